# Optimizing an MI355X kernel written in HIP

```python
import math
import jax, jax.numpy as jnp
from jax import lax
import numpy as np

D_MODEL = 1024
BATCH = 16
SEQ = 2048
DEPTH = 2

CTX_LEN = 256
GRID_W = 64
N_MIXERS = 2
N_HEADS = 8
HEAD_DIM = 64
V_DIM = 2 * HEAD_DIM
QK_WIDTH = N_HEADS * 2 * HEAD_DIM
V_WIDTH = N_HEADS * V_DIM
ROPE_THETA = 10000.0
ROPE_PAIRS = HEAD_DIM // 4
N_FOURIER_GROUPS = 4
FOURIER_GROUP = D_MODEL // N_FOURIER_GROUPS
D_FF = 2816
N_MOD = 9
Q_BLOCK = 128
EPS = 1e-6
N_ATTN_LAYERS = (DEPTH + N_MIXERS - 1) // N_MIXERS
N_FOURIER_LAYERS = DEPTH // N_MIXERS

kernel_name = "hybrid_diffattn_fnet_macaron_dit_block"


def rms_norm(x, g):
    x32 = x.astype(jnp.float32)
    y = x32 * lax.rsqrt(jnp.mean(x32 * x32, axis=-1, keepdims=True) + EPS)
    return (y * g.astype(jnp.float32)).astype(x.dtype)


def modulate(h, shift, scale):
    return h * (1 + scale) + shift


def swiglu(h, w_gu, w_d):
    g, u = jnp.split(h @ w_gu, 2, axis=-1)
    return (jax.nn.silu(g) * u) @ w_d


def ada_params(cond, w_mod, b_mod):
    m = jax.nn.silu(cond) @ w_mod + b_mod
    m = m.reshape(m.shape[:-1] + (N_MOD, 1, D_MODEL))
    return [m[..., k, :, :] for k in range(N_MOD)]


def axial_rope_tables(n_tokens):
    rows = n_tokens // GRID_W
    row = jnp.repeat(jnp.arange(rows, dtype=jnp.float32), GRID_W)
    col = jnp.tile(jnp.arange(GRID_W, dtype=jnp.float32), rows)
    inv_freq = ROPE_THETA ** (-(jnp.arange(ROPE_PAIRS, dtype=jnp.float32) / ROPE_PAIRS))
    ang = jnp.concatenate([row[:, None] * inv_freq, col[:, None] * inv_freq], axis=-1)
    ang = ang.reshape(n_tokens, 2, ROPE_PAIRS)
    return jnp.cos(ang), jnp.sin(ang)


def apply_axial_rope(t, cos, sin):
    shp = t.shape
    t = t.reshape(shp[:-1] + (2, 2, ROPE_PAIRS))
    t1, t2 = t[..., 0, :], t[..., 1, :]
    cs = cos.astype(t.dtype)[:, None, None]
    sn = sin.astype(t.dtype)[:, None, None]
    out = jnp.stack([t1 * cs - t2 * sn, t2 * cs + t1 * sn], axis=-2)
    return out.reshape(shp)


def diff_attn_core(q, k, v, lam):
    s = jnp.einsum('bqhcd,bkhcd->bhcqk', q.astype(jnp.float32), k.astype(jnp.float32))
    p = jax.nn.softmax(s * (1.0 / math.sqrt(HEAD_DIM)), axis=-1)
    a = p[:, :, 0] - lam * p[:, :, 1]
    return jnp.einsum('bhqk,bkhe->bqhe', a.astype(v.dtype), v)


def split_qkv(h, w_qkv):
    b, n, _ = h.shape
    qkv = h @ w_qkv
    q = qkv[..., :QK_WIDTH].reshape(b, n, N_HEADS, 2, HEAD_DIM)
    k = qkv[..., QK_WIDTH:2 * QK_WIDTH].reshape(b, n, N_HEADS, 2, HEAD_DIM)
    v = qkv[..., 2 * QK_WIDTH:].reshape(b, n, N_HEADS, V_DIM)
    return q, k, v


def diff_head_out(o, sub_g, w_o, lambda_init):
    b, n = o.shape[:2]
    o = rms_norm(o, sub_g) * (1.0 - lambda_init)
    return o.reshape(b, n, V_WIDTH) @ w_o


def diff_attention(hx, hy, w_qkv, w_o, q_g, k_g, lq1, lk1, lq2, lk2, sub_g,
                   lambda_init, cos, sin, with_ctx_queries):
    b, n, _ = hx.shape
    lam = (jnp.exp(jnp.sum(lq1.astype(jnp.float32) * lk1.astype(jnp.float32)))
           - jnp.exp(jnp.sum(lq2.astype(jnp.float32) * lk2.astype(jnp.float32)))
           + lambda_init)
    q, k, v = split_qkv(hx, w_qkv)
    q = apply_axial_rope(rms_norm(q, q_g), cos, sin)
    k = apply_axial_rope(rms_norm(k, k_g), cos, sin)
    qy, ky, vy = split_qkv(hy, w_qkv)
    ky = rms_norm(ky, k_g)
    keys = jnp.concatenate([ky, k], axis=1)
    vals = jnp.concatenate([vy, v], axis=1)
    nb = n // Q_BLOCK
    qb = q.reshape(b, nb, Q_BLOCK, N_HEADS, 2, HEAD_DIM).swapaxes(0, 1)
    ob = lax.map(lambda qq: diff_attn_core(qq, keys, vals, lam), qb)
    o = ob.swapaxes(0, 1).reshape(b, n, N_HEADS, V_DIM)
    out_x = diff_head_out(o, sub_g, w_o, lambda_init)
    out_y = None
    if with_ctx_queries:
        qy = rms_norm(qy, q_g)
        oy = diff_attn_core(qy, ky, vy, lam)
        out_y = diff_head_out(oy, sub_g, w_o, lambda_init)
    return out_x, out_y


def fourier_mix(h, w_f):
    b, n, d = h.shape
    hg = h.astype(jnp.float32).reshape(b, n, N_FOURIER_GROUPS, FOURIER_GROUP)
    f = jnp.fft.fft2(hg, axes=(1, 3), norm="ortho").real
    return f.reshape(b, n, d).astype(h.dtype) @ w_f


def setup_inputs(seed: int = 0) -> dict:
    key = jax.random.key(seed)
    ks = jax.random.split(key, 24)
    nrm = jax.random.normal
    f32 = jnp.float32
    NA, NF = N_ATTN_LAYERS, N_FOURIER_LAYERS
    return {
        "x": nrm(ks[0], (BATCH, SEQ, D_MODEL), f32),
        "c": nrm(ks[1], (BATCH, D_MODEL), f32),
        "ctx": nrm(ks[2], (BATCH, CTX_LEN, D_MODEL), f32),
        "c_ctx": nrm(ks[3], (D_MODEL,), f32),
        "norm_g": 1.0 + 0.05 * nrm(ks[4], (DEPTH, 3, D_MODEL), f32),
        "w_mod": 0.5 * nrm(ks[5], (DEPTH, D_MODEL, N_MOD * D_MODEL), f32) * D_MODEL ** -0.5,
        "b_mod": 0.01 * nrm(ks[6], (DEPTH, N_MOD * D_MODEL), f32),
        "ffn1_w_gu": nrm(ks[7], (DEPTH, D_MODEL, 2 * D_FF), f32) * D_MODEL ** -0.5,
        "ffn1_w_d": nrm(ks[8], (DEPTH, D_FF, D_MODEL), f32) * D_FF ** -0.5,
        "ffn2_w_gu": nrm(ks[9], (DEPTH, D_MODEL, 2 * D_FF), f32) * D_MODEL ** -0.5,
        "ffn2_w_d": nrm(ks[10], (DEPTH, D_FF, D_MODEL), f32) * D_FF ** -0.5,
        "attn_w_qkv": nrm(ks[11], (NA, D_MODEL, 2 * QK_WIDTH + V_WIDTH), f32) * D_MODEL ** -0.5,
        "attn_w_o": nrm(ks[12], (NA, V_WIDTH, D_MODEL), f32) * V_WIDTH ** -0.5,
        "attn_q_g": 1.0 + 0.05 * nrm(ks[13], (NA, HEAD_DIM), f32),
        "attn_k_g": 1.0 + 0.05 * nrm(ks[14], (NA, HEAD_DIM), f32),
        "attn_lam_q1": 0.1 * nrm(ks[15], (NA, HEAD_DIM), f32),
        "attn_lam_k1": 0.1 * nrm(ks[16], (NA, HEAD_DIM), f32),
        "attn_lam_q2": 0.1 * nrm(ks[17], (NA, HEAD_DIM), f32),
        "attn_lam_k2": 0.1 * nrm(ks[18], (NA, HEAD_DIM), f32),
        "attn_sub_g": 1.0 + 0.05 * nrm(ks[19], (NA, V_DIM), f32),
        "fourier_w": nrm(ks[20], (NF, D_MODEL, D_MODEL), f32) * D_MODEL ** -0.5,
    }


def reference(x, c, ctx, c_ctx, norm_g, w_mod, b_mod, ffn1_w_gu, ffn1_w_d, ffn2_w_gu,
              ffn2_w_d, attn_w_qkv, attn_w_o, attn_q_g, attn_k_g, attn_lam_q1, attn_lam_k1,
              attn_lam_q2, attn_lam_k2, attn_sub_g, fourier_w):
    n_lat = x.shape[1]
    cos, sin = axial_rope_tables(n_lat)
    y = ctx
    for i in range(DEPTH):
        kind = i % N_MIXERS
        ctx_needed_after = any(j % N_MIXERS == 0 for j in range(i + 1, DEPTH))
        ctx_in_layer = ctx_needed_after or kind == 0
        mx = ada_params(c, w_mod[i], b_mod[i])
        x = x + 0.5 * mx[2] * swiglu(modulate(rms_norm(x, norm_g[i, 0]), mx[0], mx[1]),
                                     ffn1_w_gu[i], ffn1_w_d[i])
        if ctx_in_layer:
            my = ada_params(c_ctx, w_mod[i], b_mod[i])
            y = y + 0.5 * my[2] * swiglu(modulate(rms_norm(y, norm_g[i, 0]), my[0], my[1]),
                                         ffn1_w_gu[i], ffn1_w_d[i])
        hx = modulate(rms_norm(x, norm_g[i, 1]), mx[3], mx[4])
        if kind == 0:
            a = i // N_MIXERS
            hy = modulate(rms_norm(y, norm_g[i, 1]), my[3], my[4])
            lambda_init = 0.8 - 0.6 * math.exp(-0.3 * i)
            ox, oy = diff_attention(hx, hy, attn_w_qkv[a], attn_w_o[a], attn_q_g[a],
                                    attn_k_g[a], attn_lam_q1[a], attn_lam_k1[a],
                                    attn_lam_q2[a], attn_lam_k2[a], attn_sub_g[a],
                                    lambda_init, cos, sin, ctx_needed_after)
            x = x + mx[5] * ox
            if ctx_needed_after:
                y = y + my[5] * oy
        else:
            f = i // N_MIXERS
            x = x + mx[5] * fourier_mix(hx, fourier_w[f])
            if ctx_needed_after:
                hy = modulate(rms_norm(y, norm_g[i, 1]), my[3], my[4])
                y = y + my[5] * fourier_mix(hy, fourier_w[f])
        x = x + 0.5 * mx[8] * swiglu(modulate(rms_norm(x, norm_g[i, 2]), mx[6], mx[7]),
                                     ffn2_w_gu[i], ffn2_w_d[i])
        if ctx_needed_after:
            y = y + 0.5 * my[8] * swiglu(modulate(rms_norm(y, norm_g[i, 2]), my[6], my[7]),
                                         ffn2_w_gu[i], ffn2_w_d[i])
    return x
```

```cpp
#include <hip/hip_runtime.h>
#include <hip/hip_cooperative_groups.h>
#include <cstdio>
#include <cstdint>
namespace cg = cooperative_groups;

#define LAS __attribute__((address_space(3)))
typedef unsigned short bf16;
typedef short bf16x8 __attribute__((ext_vector_type(8)));
typedef float f32x4 __attribute__((ext_vector_type(4)));
typedef float f32x2 __attribute__((ext_vector_type(2)));
typedef float f32x16 __attribute__((ext_vector_type(16)));
typedef unsigned u32x4 __attribute__((ext_vector_type(4)));
typedef unsigned u32x2 __attribute__((ext_vector_type(2)));
typedef __bf16 bf16x2_t __attribute__((ext_vector_type(2)));

__device__ __forceinline__ unsigned pk2(float lo, float hi) { f32x2 v = {lo, hi}; bf16x2_t b = __builtin_convertvector(v, bf16x2_t); return __builtin_bit_cast(unsigned, b); }
__device__ __forceinline__ float bf_lo(unsigned w) { return __uint_as_float(w << 16); }
__device__ __forceinline__ float bf_hi(unsigned w) { return __uint_as_float(w & 0xffff0000u); }
__device__ __forceinline__ float wave_sum(float v) {
#pragma unroll
    for (int o = 1; o < 64; o <<= 1) v += __shfl_xor(v, o);
    return v;
}

namespace pg8 {
#define PG8_LAS __attribute__((address_space(3)))
typedef unsigned short bf16_t;
constexpr int BM = 256, BK = 64, HALF = 128, HTB = HALF * BK * 2, STAGE_BYTES = 8 * HTB, NXCD = 8, WGM = 8;

__host__ __device__ __forceinline__ int lds_byte(int r, int c) { const int st = (r >> 4) * 2 + (c >> 5), rr = r & 15, cc = c & 31, ob = rr * 64 + cc * 2; return st * 1024 + (ob ^ (((ob >> 9) & 1) << 5)); }
__host__ __device__ __forceinline__ void stage_rc(int b, int& R, int& C) { const int st = b / 1024, sb = b % 1024, swz = sb ^ (((sb >> 9) & 1) << 5); R = (st >> 1) * 16 + swz / 64; C = (st & 1) * 32 + (swz % 64) / 2; }
__host__ __device__ __forceinline__ int perm32(int rho) { const int n = rho >> 4, i = rho & 15; return 8 * (i >> 2) + 4 * n + (i & 3); }

struct Unit { int pm, pn, g; };
struct Gemm { const bf16_t* A; const bf16_t* Bt; int K, lda, ldb; unsigned gstepA, gstepB; };

struct Order {
    int nM, nN, per, total, G, c, remapM, remapN;
    __device__ __forceinline__ void init(int nM_, int nN_, int nG_, int remapM_, int remapN_, int G_, int c_) { nM = nM_; nN = nN_; per = nM_ * nN_; total = per * nG_; remapM = remapM_; remapN = remapN_; G = G_; c = c_; }
    __device__ __forceinline__ bool next(int i, Unit& u) const {
        const long L = (long)i * G + c; if (L >= total) return false;
        int wgid = (int)L; { const int q = total / NXCD, r = total % NXCD, xcd = wgid % NXCD, off = wgid / NXCD; wgid = (xcd < r ? xcd * (q + 1) : r * (q + 1) + (xcd - r) * q) + off; }
        u.g = wgid / per; const int w = wgid % per;
        const int nig = WGM * nN, gid = w / nig, fm = gid * WGM, gsz = (nM - fm) < WGM ? (nM - fm) : WGM;
        int pm = fm + ((w % nig) % gsz), pn = (w % nig) / gsz;
        if (remapM) pm = (pm >> 3) * 9 + 1 + (pm & 7);
        if (remapN) pn = (pn >> 3) * 9 + 1 + (pn & 7);
        u.pm = pm; u.pn = pn; return true;
    }
    __device__ __forceinline__ void a_ready(const Unit&) const {}
    __device__ __forceinline__ void done(const Unit&) const {}
};

struct EpiBf16Split {
    static constexpr bool PERM = true, AFTER_DRAIN = false;
    bf16_t* O; int ldc; int split_cols; size_t split_stride;
    __device__ __forceinline__ void operator()(const f32x4 (&acc)[2][2][4][2], const Unit& u, int wr, int wc, int fr, int fq) const {
        const int row0 = u.pm * BM + wr * 64 + fr; int colt = u.pn * BM; bf16_t* base = O;
        { const int t = colt / split_cols; base += (size_t)t * split_stride; colt -= t * split_cols; }
        const int col0 = colt + wc * 32 + 8 * fq;
#pragma unroll
        for (int ai = 0; ai < 2; ++ai)
#pragma unroll
            for (int m = 0; m < 4; ++m) { bf16_t* rowp = base + (size_t)(row0 + ai * HALF + m * 16) * ldc + col0;
#pragma unroll
                for (int bj = 0; bj < 2; ++bj) { const f32x4 v0 = acc[ai][bj][m][0], v1 = acc[ai][bj][m][1];
                    u32x4 w; w.x = pk2(v0[0], v0[1]); w.y = pk2(v0[2], v0[3]); w.z = pk2(v1[0], v1[1]); w.w = pk2(v1[2], v1[3]);
                    *(u32x4*)(rowp + bj * HALF) = w; } }
    }
};
struct EpiSwiglu {
    static constexpr bool PERM = true, AFTER_DRAIN = false;
    bf16_t* O;
    __device__ __forceinline__ void operator()(const f32x4 (&acc)[2][2][4][2], const Unit& u, int wr, int wc, int fr, int fq) const {
        const int row0 = u.pm * BM + wr * 64 + fr, col0 = u.pn * HALF + wc * 32 + 8 * fq;
#pragma unroll
        for (int ai = 0; ai < 2; ++ai)
#pragma unroll
            for (int m = 0; m < 4; ++m) { bf16_t* rowp = O + (size_t)(row0 + ai * HALF + m * 16) * 2816 + col0;
                float v[8];
#pragma unroll
                for (int n = 0; n < 2; ++n)
#pragma unroll
                    for (int j = 0; j < 4; ++j) { const float g = acc[ai][0][m][n][j], uu = acc[ai][1][m][n][j];
                        v[4 * n + j] = g * uu * __builtin_amdgcn_rcpf(1.0f + __builtin_amdgcn_exp2f(-1.44269504089f * g)); }
                u32x4 w; w.x = pk2(v[0], v[1]); w.y = pk2(v[2], v[3]); w.z = pk2(v[4], v[5]); w.w = pk2(v[6], v[7]);
                *(u32x4*)rowp = w; }
    }
};
struct EpiGateRes {
    static constexpr bool PERM = false, AFTER_DRAIN = false;
    const float* resx; const float* resy; float* outx; float* outy; const float* ada; int kg; float coef;
    __device__ __forceinline__ void operator()(const f32x4 (&acc)[2][2][4][2], const Unit& u, int wr, int wc, int fr, int fq) const {
        const int b = u.pm / 9, j = u.pm % 9; const float* rb; float* ob; int s;
        if (j == 0) { const size_t off = (size_t)b * 256 * 1024; rb = resy + off; ob = outy + off; s = 16; }
        else { const size_t off = ((size_t)b * 2048 + (size_t)(j - 1) * 256) * 1024; rb = resx + off; ob = outx + off; s = b; }
        const float* gate = ada + (size_t)(s * 9 + kg) * 1024;
        const int row0 = wr * 64 + fr, col0 = u.pn * BM + wc * 32 + 4 * fq;
        f32x4 gv[2][2];
#pragma unroll
        for (int bj = 0; bj < 2; ++bj)
#pragma unroll
            for (int n = 0; n < 2; ++n) gv[bj][n] = *(const f32x4*)(gate + col0 + bj * HALF + n * 16) * coef;
#pragma unroll
        for (int ai = 0; ai < 2; ++ai)
#pragma unroll
            for (int m = 0; m < 4; ++m) { const size_t roff = (size_t)(row0 + ai * HALF + m * 16) * 1024 + col0;
#pragma unroll
                for (int bj = 0; bj < 2; ++bj)
#pragma unroll
                    for (int n = 0; n < 2; ++n) { const f32x4 r = *(const f32x4*)(rb + roff + bj * HALF + n * 16);
                        *(f32x4*)(ob + roff + bj * HALF + n * 16) = r + gv[bj][n] * acc[ai][bj][m][n]; } }
    }
};
struct EpiChan {
    static constexpr bool PERM = true, AFTER_DRAIN = false;
    bf16_t* XT;
    __device__ __forceinline__ void operator()(const f32x4 (&acc)[2][2][4][2], const Unit& u, int wr, int wc, int fr, int fq) const {
        const int b = u.pn / 9, jt = u.pn % 9 - 1;
        bf16_t* base = XT + (size_t)(b * 1024 + u.g * 256) * 4096 + u.pm * 2048 + jt * 256;
        const int row0 = wr * 64 + fr, col0 = wc * 32 + 8 * fq;
#pragma unroll
        for (int ai = 0; ai < 2; ++ai)
#pragma unroll
            for (int m = 0; m < 4; ++m) { bf16_t* rowp = base + (size_t)(row0 + ai * HALF + m * 16) * 4096 + col0;
#pragma unroll
                for (int bj = 0; bj < 2; ++bj) { const f32x4 v0 = acc[ai][bj][m][0], v1 = acc[ai][bj][m][1];
                    u32x4 w; w.x = pk2(v0[0], v0[1]); w.y = pk2(v0[2], v0[3]); w.z = pk2(v1[0], v1[1]); w.w = pk2(v1[2], v1[3]);
                    *(u32x4*)(rowp + bj * HALF) = w; } }
    }
};

template <class Epi, class Sched, bool ALIGN_EPI = true>
__device__ __forceinline__ void gemm_phase(PG8_LAS unsigned char* lds, const Gemm g, const Sched& S, const Epi& E) {
    int tid = threadIdx.x; asm volatile("" : "+v"(tid));
    const int wid = __builtin_amdgcn_readfirstlane(tid >> 6), lane = tid & 63, wr = wid >> 2, wc = wid & 3, fr = lane & 15, fq = lane >> 4;
    int K = g.K; asm volatile("" : "+s"(K));
    const int nt = K / BK;
    unsigned voffA[2], voffB[2];
#pragma unroll
    for (int i = 0; i < 2; ++i) { int R, C; stage_rc(tid * 16 + i * 8192, R, C); const int Rb = Epi::PERM ? ((R & ~31) + perm32(R & 31)) : R;
        voffA[i] = (unsigned)(R * g.lda + C) * 2u; voffB[i] = (unsigned)(Rb * g.ldb + C) * 2u; }
    const size_t kstep = (size_t)(BK * 2);
    const size_t hstepA = (size_t)HALF * g.lda * 2, hstepB = (size_t)HALF * g.ldb * 2;
    const size_t tstepA = 2 * hstepA, tstepB = 2 * hstepB;
    const unsigned ldsw = (unsigned)wid * 1024u;
    const int aoff = lds_byte(wr * 64 + fr, fq * 8), boff = lds_byte(wc * 32 + fr, fq * 8);
#define PG8_SA(b, h) (((b) * 2 + (h)) * HTB)
#define PG8_SB(b, h) ((4 + (b) * 2 + (h)) * HTB)
#define PG8_STAGE(bufoff, gbase, voff) do { _Pragma("unroll") for (int _i = 0; _i < 2; ++_i) \
        __builtin_amdgcn_global_load_lds((const unsigned*)((const char*)(gbase) + (voff)[_i]), (PG8_LAS unsigned*)(lds + (bufoff) + ldsw + _i * 8192), 16, 0, 0); } while (0)
#define PG8_LDA(dst, b, h) do { _Pragma("unroll") for (int m = 0; m < 4; ++m) _Pragma("unroll") for (int k = 0; k < 2; ++k) dst[m][k] = *(const PG8_LAS bf16x8*)(lds + PG8_SA(b, h) + aoff + m * 2048 + k * 1024); } while (0)
#define PG8_LDB(dst, b, h) do { _Pragma("unroll") for (int n = 0; n < 2; ++n) _Pragma("unroll") for (int k = 0; k < 2; ++k) dst[n][k] = *(const PG8_LAS bf16x8*)(lds + PG8_SB(b, h) + boff + n * 2048 + k * 1024); } while (0)
#define PG8_MMA(ai, bj, At, Bt) do { __builtin_amdgcn_s_setprio(1); _Pragma("unroll") for (int m = 0; m < 4; ++m) _Pragma("unroll") for (int n = 0; n < 2; ++n) _Pragma("unroll") for (int k = 0; k < 2; ++k) \
        acc[ai][bj][m][n] = __builtin_amdgcn_mfma_f32_16x16x32_bf16(Bt[n][k], At[m][k], acc[ai][bj][m][n], 0, 0, 0); __builtin_amdgcn_s_setprio(0); } while (0)
#define PG8_WAIT_V(n) asm volatile("s_waitcnt vmcnt(" #n ")" ::: "memory")
#define PG8_WAIT_L(n) asm volatile("s_waitcnt lgkmcnt(" #n ")" ::: "memory")
#define PG8_BAR __builtin_amdgcn_s_barrier()
#define PG8_SCHED __builtin_amdgcn_sched_barrier(0)
    Unit cur, nxt; int ui = 0;
    if (!S.next(0, cur)) return;
    f32x4 acc[2][2][4][2];
#pragma unroll
    for (int a = 0; a < 2; ++a)
#pragma unroll
        for (int b = 0; b < 2; ++b)
#pragma unroll
            for (int m = 0; m < 4; ++m)
#pragma unroll
                for (int n = 0; n < 2; ++n) acc[a][b][m][n] = (f32x4){0.f, 0.f, 0.f, 0.f};
    bf16x8 At[4][2], B0[2][2], B1[2][2];
    const char* cA = (const char*)g.A + (size_t)cur.pm * tstepA + (size_t)cur.g * g.gstepA; const char* cB = (const char*)g.Bt + (size_t)cur.pn * tstepB + (size_t)cur.g * g.gstepB;
    S.a_ready(cur);
    PG8_STAGE(PG8_SB(0, 0), cB, voffB); PG8_STAGE(PG8_SB(0, 1), cB + hstepB, voffB); PG8_STAGE(PG8_SA(0, 0), cA, voffA); PG8_STAGE(PG8_SA(0, 1), cA + hstepA, voffA);
    if (wr == 1) PG8_BAR;
    PG8_WAIT_V(2); PG8_BAR;
    PG8_STAGE(PG8_SB(1, 0), cB + kstep, voffB); PG8_STAGE(PG8_SA(1, 0), cA + kstep, voffA); PG8_STAGE(PG8_SB(1, 1), cB + hstepB + kstep, voffB);
    PG8_WAIT_V(6); PG8_BAR;
    for (;;) {
        const bool has_next = S.next(ui + 1, nxt);
        const char* nA = has_next ? (const char*)g.A + (size_t)nxt.pm * tstepA + (size_t)nxt.g * g.gstepA : cA; const char* nB = has_next ? (const char*)g.Bt + (size_t)nxt.pn * tstepB + (size_t)nxt.g * g.gstepB : cB;
        for (int t = 0; t < nt; t += 2) {
            const bool last = (t == nt - 2);
            const char* a1 = cA + (size_t)(t + 1) * kstep;
            const char* a2 = last ? nA : cA + (size_t)(t + 2) * kstep; const char* b2 = last ? nB : cB + (size_t)(t + 2) * kstep;
            const char* a3 = a2 + kstep; const char* b3 = b2 + kstep;
            if (last && has_next) S.a_ready(nxt);
            PG8_LDB(B0, 0, 0); PG8_LDB(B1, 0, 1); PG8_SCHED; PG8_LDA(At, 0, 0); PG8_STAGE(PG8_SA(1, 1), a1 + hstepA, voffA);
            PG8_WAIT_V(8); PG8_WAIT_L(0); PG8_BAR; PG8_MMA(0, 0, At, B0); PG8_MMA(0, 1, At, B1); PG8_BAR; PG8_SCHED;
            PG8_LDA(At, 0, 1); PG8_STAGE(PG8_SB(0, 0), b2, voffB); PG8_STAGE(PG8_SB(0, 1), b2 + hstepB, voffB); PG8_STAGE(PG8_SA(0, 0), a2, voffA);
            PG8_WAIT_V(8); PG8_WAIT_L(0); PG8_BAR; PG8_MMA(1, 0, At, B0); PG8_MMA(1, 1, At, B1); PG8_BAR; PG8_SCHED;
            PG8_LDB(B0, 1, 0); PG8_LDB(B1, 1, 1); PG8_SCHED; PG8_LDA(At, 1, 0); PG8_STAGE(PG8_SA(0, 1), a2 + hstepA, voffA);
            PG8_WAIT_V(8); PG8_WAIT_L(0); PG8_BAR; PG8_MMA(0, 0, At, B0); PG8_MMA(0, 1, At, B1); PG8_BAR; PG8_SCHED;
            PG8_LDA(At, 1, 1); PG8_STAGE(PG8_SB(1, 0), b3, voffB); PG8_STAGE(PG8_SB(1, 1), b3 + hstepB, voffB); PG8_STAGE(PG8_SA(1, 0), a3, voffA);
            PG8_WAIT_V(8); PG8_WAIT_L(0); PG8_BAR; PG8_MMA(1, 0, At, B0); PG8_MMA(1, 1, At, B1); PG8_BAR; PG8_SCHED;
        }
        if constexpr (ALIGN_EPI) { if (wr == 0) PG8_BAR; }
        E(acc, cur, wr, wc, fr, fq); S.done(cur);
        if (!has_next) break;
#pragma unroll
        for (int a = 0; a < 2; ++a)
#pragma unroll
            for (int b = 0; b < 2; ++b)
#pragma unroll
                for (int m = 0; m < 4; ++m)
#pragma unroll
                    for (int n = 0; n < 2; ++n) acc[a][b][m][n] = (f32x4){0.f, 0.f, 0.f, 0.f};
        cur = nxt; cA = nA; cB = nB; ++ui;
        if constexpr (ALIGN_EPI) { if (wr == 1) PG8_BAR; }
    }
    PG8_WAIT_V(0);
    if constexpr (!ALIGN_EPI) { if (wr == 0) PG8_BAR; }
    PG8_BAR;
#undef PG8_SA
#undef PG8_SB
#undef PG8_STAGE
#undef PG8_LDA
#undef PG8_LDB
#undef PG8_MMA
#undef PG8_WAIT_V
#undef PG8_WAIT_L
#undef PG8_BAR
#undef PG8_SCHED
}
}


#define XB_TMO      128
#define XB_XCNT(j)  (256  + 64 * (j))
#define XB_XSUB(j)  (1280 + 64 * (j))
#define XB_XGEN(j)  (2304 + 64 * (j))
#define XB_TOP      3328
#define XB_TOPGEN   3392
#define XCD_BAR_WORDS 3456
#define XB_SPIN_CAP (1u << 18)
__device__ __forceinline__ unsigned xb_ld(unsigned* p)              { return __hip_atomic_load(p, __ATOMIC_RELAXED, __HIP_MEMORY_SCOPE_AGENT); }
__device__ __forceinline__ unsigned xb_add(unsigned* p, unsigned v) { return __hip_atomic_fetch_add(p, v, __ATOMIC_RELAXED, __HIP_MEMORY_SCOPE_AGENT); }
__device__ __forceinline__ unsigned xb_xcc_id() { return (unsigned)__builtin_amdgcn_s_getreg((3 << 11) | 20) & 0xFu; }
#define XB_SPIN(cond, bar) do { unsigned _sp = 0; while (cond) { __builtin_amdgcn_s_sleep(1); \
    if ((++_sp & 255u) == 0u) { if (xb_ld(&(bar)[XB_TMO])) break; if (_sp > XB_SPIN_CAP) { atomicAdd(&(bar)[XB_TMO], 1u); break; } } } } while (0)
struct XcdBarrier { unsigned* bar; unsigned x; volatile LAS unsigned* st; };
__device__ __forceinline__ XcdBarrier xcd_barrier_post(unsigned* bar, volatile LAS unsigned* st) {
    XcdBarrier b; b.bar = bar; b.x = xb_xcc_id(); b.st = st;
    if (threadIdx.x == 0) (void)xb_add(&bar[XB_XCNT(b.x)], 1u);
    return b;
}
__device__ __forceinline__ void xcd_barrier_complete(unsigned* bar, unsigned x, unsigned& nloc, unsigned& nx) {
    const unsigned G = gridDim.x * gridDim.y * gridDim.z;
    unsigned sum, cnt, mine, sp = 0u;
    for (;;) {
        sum = 0u; cnt = 0u; mine = 0u;
#pragma unroll
        for (unsigned j = 0; j < 16; ++j) { const unsigned c = xb_ld(&bar[XB_XCNT(j)]); sum += c; cnt += (c > 0u) ? 1u : 0u; mine = (j == x) ? c : mine; }
        if (sum == G) break;
        __builtin_amdgcn_s_sleep(1);
        if ((++sp & 255u) == 0u) { if (xb_ld(&bar[XB_TMO])) break; if (sp > XB_SPIN_CAP) { atomicAdd(&bar[XB_TMO], 1u); break; } }
    }
    nloc = mine > 0u ? mine : 1u; nx = cnt > 0u ? cnt : 1u;
}
__device__ __forceinline__ void xcd_barrier(const XcdBarrier& b) {
    asm volatile("s_waitcnt vmcnt(0)" ::: "memory");
    __syncthreads();
    if (threadIdx.x == 0) {
        unsigned* bar = b.bar;
        __builtin_amdgcn_s_waitcnt(0);
        unsigned nloc = b.st[0], nx = b.st[1];
        if (nloc == 0u) { xcd_barrier_complete(bar, b.x, nloc, nx); b.st[0] = nloc; b.st[1] = nx; }
        const unsigned old = xb_add(&bar[XB_XSUB(b.x)], 1u);
        const unsigned gen = old / nloc;
        if (old + 1u == (gen + 1u) * nloc) {
            __builtin_amdgcn_fence(__ATOMIC_RELEASE, "agent");
            asm volatile("s_waitcnt vmcnt(0)" ::: "memory");
            const unsigned og = xb_add(&bar[XB_TOP], 1u);
            const unsigned tg = og / nx;
            if (og + 1u == (tg + 1u) * nx) xb_add(&bar[XB_TOPGEN], 1u);
            else XB_SPIN(xb_ld(&bar[XB_TOPGEN]) == tg, bar);
            __builtin_amdgcn_fence(__ATOMIC_ACQUIRE, "agent");
            xb_add(&bar[XB_XGEN(b.x)], 1u);
            asm volatile("s_waitcnt vmcnt(0)" ::: "memory");
        } else {
            XB_SPIN(xb_ld(&bar[XB_XGEN(b.x)]) == gen, bar);
            __builtin_amdgcn_fence(__ATOMIC_ACQUIRE, "agent");
            asm volatile("s_waitcnt vmcnt(0)" ::: "memory");
        }
    }
    __syncthreads();
}

constexpr int DM = 1024, NB = 16, SEQ = 2048, CTX = 256, TOK = 2304, MC = NB * TOK  , MX = NB * SEQ  , DFF = 2816, NGU = 5632, NMOD = 9216;
constexpr float EPS = 1e-6f;
constexpr float QSCALE = 0.125f * 1.44269504089f;
constexpr size_t MiB = 1u << 20;
constexpr size_t WS_ADA = 1 * MiB;
constexpr size_t WS_SCAL = 3 * MiB;
constexpr size_t WS_ROPE = 3 * MiB + 4096;
constexpr size_t WS_WGU = 4 * MiB;
constexpr size_t WS_WD = 48 * MiB;
constexpr size_t WS_WQKV = 70 * MiB;
constexpr size_t WS_WO = 76 * MiB;
constexpr size_t WS_WF = 78 * MiB;
constexpr size_t WS_DFTS = 80 * MiB;
constexpr size_t WS_DFTC = 96 * MiB;
constexpr size_t WS_Y1 = 98 * MiB;
constexpr size_t WS_HB = 114 * MiB;
constexpr size_t WS_BIG = 186 * MiB;
constexpr size_t WS_END = 402 * MiB;
constexpr size_t WGU_SZ = (size_t)NGU * DM * 2, WD_SZ = (size_t)DM * DFF * 2;
constexpr size_t QK_STRIDE = (size_t)MC * DM;
constexpr int LDS_BYTES = 147456;

__device__ __forceinline__ void transpose_item(const float* W, int K, int N, bf16* WT, bool gu, LAS float* scr, int item, int lane) {
    const int nblk = N / 64, kb = item / nblk, nb = item % nblk, k0 = 64 * kb, n0 = 64 * nb;
    int r0 = n0;
    if (gu) { const int jj = (n0 < DFF) ? n0 : n0 - DFF; r0 = (jj >> 7) * 256 + (jj & 127) + ((n0 < DFF) ? 0 : 128); }
    const int n4 = lane & 15, kr = lane >> 4;
    const float* wp = W + (size_t)(k0 + kr) * N + n0 + 4 * n4;
    f32x4 v[16];
#pragma unroll
    for (int i = 0; i < 16; ++i) v[i] = *(const f32x4*)(wp + (size_t)(4 * i) * N);
#pragma unroll
    for (int i = 0; i < 16; ++i) { LAS float* d = scr + (4 * i + kr) * 65 + 4 * n4; d[0] = v[i].x; d[1] = v[i].y; d[2] = v[i].z; d[3] = v[i].w; }
    asm volatile("s_waitcnt lgkmcnt(0)" ::: "memory");
    const int c = lane & 7;
#pragma unroll
    for (int j = 0; j < 8; ++j) { const int n = (lane >> 3) + 8 * j; const LAS float* q = scr + (8 * c) * 65 + n;
        u32x4 o; o.x = pk2(q[0 * 65], q[1 * 65]); o.y = pk2(q[2 * 65], q[3 * 65]); o.z = pk2(q[4 * 65], q[5 * 65]); o.w = pk2(q[6 * 65], q[7 * 65]);
        *(u32x4*)(WT + (size_t)(r0 + n) * K + k0 + 8 * c) = o; }
    asm volatile("s_waitcnt lgkmcnt(0)" ::: "memory");
}

struct Args { const float* in[21]; float* out; unsigned char* ws; int ph_lo, ph_hi; };

__device__ __forceinline__ void norm_phase(const float* xsrc, const float* ysrc, const float* gvec, const float* ada, int kshift, bf16* hb, bool with_ctx, int vcu, int NGW) {
    int tid = threadIdx.x; asm volatile("" : "+v"(tid));
    const int lane = tid & 63, gw = vcu * 8 + __builtin_amdgcn_readfirstlane(tid >> 6);
    const int nrows = with_ctx ? MC : MX;
    for (int i = gw; i < nrows; i += NGW) {
        int b, j;
        if (with_ctx) { b = i / TOK; j = i % TOK; } else { b = i >> 11; j = 256 + (i & 2047); }
        const float* src; int s;
        if (j < CTX) { src = ysrc + ((size_t)b * CTX + j) * DM; s = 16; } else { src = xsrc + ((size_t)b * SEQ + (j - CTX)) * DM; s = b; }
        const f32x4* xr = (const f32x4*)src + lane;
        f32x4 v[4]; float ss = 0.f;
#pragma unroll
        for (int q = 0; q < 4; ++q) { v[q] = xr[64 * q]; ss += (v[q].x * v[q].x + v[q].y * v[q].y) + (v[q].z * v[q].z + v[q].w * v[q].w); }
        const float rstd = rsqrtf(wave_sum(ss) * (1.f / DM) + EPS);
        const f32x4* gp = (const f32x4*)gvec + lane; const f32x4* shp = (const f32x4*)(ada + (size_t)(s * 9 + kshift) * DM) + lane; const f32x4* scp = shp + DM / 4;
        u32x2* o8 = (u32x2*)(hb + ((size_t)b * TOK + j) * DM) + lane;
#pragma unroll
        for (int q = 0; q < 4; ++q) { const f32x4 gg = gp[64 * q], sh = shp[64 * q], sc = scp[64 * q];
            const f32x4 o = v[q] * rstd * gg * (sc + 1.0f) + sh;
            u32x2 w; w.x = pk2(o.x, o.y); w.y = pk2(o.z, o.w); o8[64 * q] = w; }
    }
}

__device__ __forceinline__ void ada_phase(LAS unsigned char* lds, const float* c, const float* c_ctx, const float* w_mod, const float* b_mod, float* ada, int G, int bid) {
    int tid = threadIdx.x; asm volatile("" : "+v"(tid));
    LAS float* sc = (LAS float*)lds;
    LAS float* red = (LAS float*)(lds + 17 * 1024 * 4);
    for (int i = tid; i < 17 * 1024; i += 512) { const int s = i >> 10, k = i & 1023; const float v = (s < 16) ? c[s * 1024 + k] : c_ctx[k]; sc[i] = v / (1.0f + __expf(-v)); }
    __syncthreads();
    const int lane = tid & 63, w = tid >> 6, n4 = lane & 15, kr = lane >> 4;
    for (int item = bid; item < 288; item += G) {
        const int layer = item / 144, c0 = (item % 144) * 64;
        const float* W = w_mod + (size_t)layer * 1024 * NMOD + (size_t)(w * 128 + kr) * NMOD + c0 + 4 * n4;
        const LAS float* scp = sc + w * 128 + kr;
        f32x4 acc[17];
#pragma unroll
        for (int s = 0; s < 17; ++s) acc[s] = (f32x4){0.f, 0.f, 0.f, 0.f};
#pragma unroll 4
        for (int st = 0; st < 32; ++st) { const f32x4 wv = *(const f32x4*)(W + (size_t)(4 * st) * NMOD);
#pragma unroll
            for (int s = 0; s < 17; ++s) acc[s] += wv * scp[s * 1024 + 4 * st]; }
#pragma unroll
        for (int s = 0; s < 17; ++s)
#pragma unroll
            for (int e = 0; e < 4; ++e) { float v = acc[s][e]; v += __shfl_xor(v, 16); v += __shfl_xor(v, 32); if (lane < 16) red[(w * 17 + s) * 64 + 4 * n4 + e] = v; }
        __syncthreads();
        for (int o = tid; o < 17 * 64; o += 512) { const int s = o >> 6, cc = o & 63; float sum = 0.f;
#pragma unroll
            for (int q = 0; q < 8; ++q) sum += red[(q * 17 + s) * 64 + cc];
            ada[(size_t)(layer * 17 + s) * NMOD + c0 + cc] = sum + b_mod[layer * NMOD + c0 + cc]; }
        __syncthreads();
    }
}

__device__ __forceinline__ void qknorm_phase(bf16* Qr, bf16* Kr, const float* qg, const float* kg, const f32x2* rope, int vcu, int NGW) {
    int tid = threadIdx.x; asm volatile("" : "+v"(tid));
    const int lane = tid & 63, gw = vcu * 8 + __builtin_amdgcn_readfirstlane(tid >> 6);
    for (int it = gw; it < MC * 2; it += NGW) {
        const int r = it >> 1, which = it & 1, b = r / TOK, j = r % TOK;
        if (j < CTX && which == 0) continue;
        bf16* p = (which ? Kr : Qr) + (size_t)r * DM + lane * 16;
        const u32x4 w0 = *(const u32x4*)p, w1 = *(const u32x4*)(p + 8);
        float v[16];
        v[0] = bf_lo(w0.x); v[1] = bf_hi(w0.x); v[2] = bf_lo(w0.y); v[3] = bf_hi(w0.y); v[4] = bf_lo(w0.z); v[5] = bf_hi(w0.z); v[6] = bf_lo(w0.w); v[7] = bf_hi(w0.w);
        v[8] = bf_lo(w1.x); v[9] = bf_hi(w1.x); v[10] = bf_lo(w1.y); v[11] = bf_hi(w1.y); v[12] = bf_lo(w1.z); v[13] = bf_hi(w1.z); v[14] = bf_lo(w1.w); v[15] = bf_hi(w1.w);
        float ss = 0.f;
#pragma unroll
        for (int i = 0; i < 16; ++i) ss += v[i] * v[i];
        ss += __shfl_xor(ss, 1); ss += __shfl_xor(ss, 2);
        const float rstd = rsqrtf(ss * (1.f / 64.f) + EPS);
        const float* gn = (which ? kg : qg) + (lane & 3) * 16;
#pragma unroll
        for (int i = 0; i < 16; ++i) v[i] = v[i] * rstd * gn[i];
        if (j >= CTX) {
            const int pos = j - CTX, axis = (lane >> 1) & 1, half = lane & 1;
            const f32x2* cs = rope + ((size_t)pos * 2 + axis) * 16;
#pragma unroll
            for (int i = 0; i < 16; ++i) { const float pv = __shfl_xor(v[i], 1); const f32x2 t = cs[i];
                v[i] = half ? (v[i] * t.x + pv * t.y) : (v[i] * t.x - pv * t.y); }
        }
        if (which == 0) {
#pragma unroll
            for (int i = 0; i < 16; ++i) v[i] *= QSCALE;
        }
        u32x4 o0, o1;
        o0.x = pk2(v[0], v[1]); o0.y = pk2(v[2], v[3]); o0.z = pk2(v[4], v[5]); o0.w = pk2(v[6], v[7]);
        o1.x = pk2(v[8], v[9]); o1.y = pk2(v[10], v[11]); o1.z = pk2(v[12], v[13]); o1.w = pk2(v[14], v[15]);
        *(u32x4*)p = o0; *(u32x4*)(p + 8) = o1;
    }
}

constexpr int AT_ROW = 144, AT_BUF = 256 * AT_ROW  , AT_X = 0, AT_OUT = 2 * AT_BUF  , AT_OROW = 272;
__device__ __forceinline__ int crow(int i, int h) { return (i & 3) + 8 * (i >> 2) + 4 * h; }
__device__ __forceinline__ void attn_phase(LAS unsigned char* lds, const bf16* Q, const bf16* Kt, const bf16* VT, bf16* O, const float* sub_g, float lam, float cref, float out_scale, int G, int bid) {
    int tid = threadIdx.x; asm volatile("" : "+v"(tid));
    const int lane = tid & 63, r = lane & 31, h = lane >> 5, wid = __builtin_amdgcn_readfirstlane(tid >> 6), c = wid & 1, qg = wid >> 1;
    const int vcu = (G % 8 == 0) ? (bid % 8) * (G / 8) + bid / 8 : bid;
    const int srow = tid >> 3, spart = tid & 7;
    const int rsw = (r & 19) | ((r & 4) << 1) | ((r & 8) >> 1);
    const int koff = (c * 64 + rsw) * AT_ROW + h * 16, voff = (128 + r) * AT_ROW + h * 16;
    for (int unit = vcu; unit < NB * 8 * 16; unit += G) {
        const int bh = unit >> 4, qb = unit & 15, b = bh >> 3, hh = bh & 7, q0 = qb * 128;
        const bf16* qp = Q + ((size_t)b * TOK + CTX + q0 + qg * 32 + r) * DM + hh * 128 + c * 64 + h * 8;
        bf16x8 qf[4];
#pragma unroll
        for (int d0 = 0; d0 < 4; ++d0) qf[d0] = *(const bf16x8*)(qp + d0 * 16);
        const bf16* kg0 = Kt + ((size_t)b * TOK + srow) * DM + hh * 128 + spart * 8;
        const bf16* vg0 = VT + ((size_t)(b * 1024 + hh * 128 + srow)) * TOK + spart * 8;
        f32x16 o[4];
#pragma unroll
        for (int d = 0; d < 4; ++d)
#pragma unroll
            for (int i = 0; i < 16; ++i) o[d][i] = 0.f;
        float lsum = 0.f;
        u32x4 st[4];
        st[0] = *(const u32x4*)(kg0); st[1] = *(const u32x4*)(kg0 + 64); st[2] = *(const u32x4*)(vg0); st[3] = *(const u32x4*)(vg0 + (size_t)64 * TOK);
#pragma unroll
        for (int i = 0; i < 4; ++i) *(LAS u32x4*)(lds + (srow + 64 * i) * AT_ROW + spart * 16) = st[i];
        __syncthreads();
        for (int t = 0; t < TOK / 64; ++t) {
            const int buf = (t & 1) * AT_BUF;
            if (t + 1 < TOK / 64) { const bf16* kg = kg0 + (size_t)(t + 1) * 64 * DM; const bf16* vg = vg0 + (t + 1) * 64;
                st[0] = *(const u32x4*)(kg); st[1] = *(const u32x4*)(kg + 64); st[2] = *(const u32x4*)(vg); st[3] = *(const u32x4*)(vg + (size_t)64 * TOK); }
            bf16x8 pf[2][2];
#pragma unroll
            for (int blk = 0; blk < 2; ++blk) {
                f32x16 s;
#pragma unroll
                for (int i = 0; i < 16; ++i) s[i] = -cref;
#pragma unroll
                for (int d0 = 0; d0 < 4; ++d0) { const bf16x8 kf = *(const LAS bf16x8*)(lds + buf + koff + blk * 32 * AT_ROW + d0 * 32);
                    s = __builtin_amdgcn_mfma_f32_32x32x16_bf16(kf, qf[d0], s, 0, 0, 0); }
#pragma unroll
                for (int i = 0; i < 16; ++i) { s[i] = __builtin_amdgcn_exp2f(s[i]); lsum += s[i]; }
#pragma unroll
                for (int sx = 0; sx < 2; ++sx) { u32x4 w; w.x = pk2(s[8 * sx], s[8 * sx + 1]); w.y = pk2(s[8 * sx + 2], s[8 * sx + 3]); w.z = pk2(s[8 * sx + 4], s[8 * sx + 5]); w.w = pk2(s[8 * sx + 6], s[8 * sx + 7]);
                    pf[blk][sx] = __builtin_bit_cast(bf16x8, w); }
            }
#pragma unroll
            for (int dvb = 0; dvb < 4; ++dvb)
#pragma unroll
                for (int blk = 0; blk < 2; ++blk)
#pragma unroll
                    for (int sx = 0; sx < 2; ++sx) { const bf16x8 vf = *(const LAS bf16x8*)(lds + buf + voff + dvb * 32 * AT_ROW + blk * 64 + sx * 32);
                        o[dvb] = __builtin_amdgcn_mfma_f32_32x32x16_bf16(vf, pf[blk][sx], o[dvb], 0, 0, 0); }
            if (t + 1 < TOK / 64) {
#pragma unroll
                for (int i = 0; i < 4; ++i) *(LAS u32x4*)(lds + (AT_BUF - buf) + (srow + 64 * i) * AT_ROW + spart * 16) = st[i];
            }
            __syncthreads();
        }
        const float l = lsum + __shfl_xor(lsum, 32);
        LAS float* X = (LAS float*)(lds + AT_X);
        if (c == 1) { const float f = lam / l;
#pragma unroll
            for (int dvb = 0; dvb < 4; ++dvb)
#pragma unroll
                for (int i = 0; i < 16; ++i) X[(qg * 128 + dvb * 32 + crow(i, h)) * 32 + r] = o[dvb][i] * f; }
        __syncthreads();
        if (c == 0) { const float f = 1.0f / l; float ss = 0.f;
#pragma unroll
            for (int dvb = 0; dvb < 4; ++dvb)
#pragma unroll
                for (int i = 0; i < 16; ++i) { const float v = o[dvb][i] * f - X[(qg * 128 + dvb * 32 + crow(i, h)) * 32 + r]; o[dvb][i] = v; ss += v * v; }
            ss += __shfl_xor(ss, 32);
            const float rstd = rsqrtf(ss * (1.f / 128.f) + EPS) * out_scale;
#pragma unroll
            for (int dvb = 0; dvb < 4; ++dvb)
#pragma unroll
                for (int i4 = 0; i4 < 4; ++i4) { const int dv = dvb * 32 + 8 * i4 + 4 * h; const f32x4 sg = *(const f32x4*)(sub_g + dv);
                    u32x2 w; w.x = pk2(o[dvb][4 * i4] * rstd * sg.x, o[dvb][4 * i4 + 1] * rstd * sg.y); w.y = pk2(o[dvb][4 * i4 + 2] * rstd * sg.z, o[dvb][4 * i4 + 3] * rstd * sg.w);
                    *(LAS u32x2*)(lds + AT_OUT + (qg * 32 + r) * AT_OROW + dv * 2) = w; } }
        __syncthreads();
#pragma unroll
        for (int i = 0; i < 4; ++i) { const int ch = tid + 512 * i, row = ch >> 4, part = ch & 15;
            const u32x4 v = *(const LAS u32x4*)(lds + AT_OUT + row * AT_OROW + part * 16);
            *(u32x4*)(O + ((size_t)b * TOK + CTX + q0 + row) * DM + hh * 128 + part * 8) = v; }
    }
    __syncthreads();
}

__global__ void __launch_bounds__(512, 2) fwd_kernel(Args args) {
    extern __shared__ __attribute__((aligned(16))) unsigned char lds_raw[];
    LAS unsigned char* lds = (LAS unsigned char*)lds_raw;
    cg::grid_group grid = cg::this_grid();
    const int tid = threadIdx.x, lane = tid & 63, wave = __builtin_amdgcn_readfirstlane(tid >> 6);
    const int G = gridDim.x, bid = blockIdx.x;
    const int vcu = (G % 8 == 0) ? (bid % 8) * (G / 8) + bid / 8 : bid;
    const int gw = vcu * 8 + wave, NGW = G * 8;
    unsigned char* ws = args.ws;
    const float* x_in = args.in[0]; const float* c_in = args.in[1]; const float* ctx_in = args.in[2]; const float* c_ctx = args.in[3];
    const float* norm_g = args.in[4]; const float* w_mod = args.in[5]; const float* b_mod = args.in[6];

    const float* w_qkv = args.in[11]; const float* w_o = args.in[12]; const float* q_g = args.in[13]; const float* k_g = args.in[14];
    const float* lq1 = args.in[15]; const float* lk1 = args.in[16]; const float* lq2 = args.in[17]; const float* lk2 = args.in[18];
    const float* sub_g = args.in[19]; const float* w_f = args.in[20];
    float* out = args.out;
    float* ada = (float*)(ws + WS_ADA); float* scal = (float*)(ws + WS_SCAL); f32x2* rope = (f32x2*)(ws + WS_ROPE);
    bf16* WQKV = (bf16*)(ws + WS_WQKV); bf16* WO = (bf16*)(ws + WS_WO); bf16* WF = (bf16*)(ws + WS_WF);
    bf16* DFTS = (bf16*)(ws + WS_DFTS); bf16* DFTC = (bf16*)(ws + WS_DFTC);
    float* Y1 = (float*)(ws + WS_Y1); bf16* HB = (bf16*)(ws + WS_HB); bf16* BIG = (bf16*)(ws + WS_BIG);
    const int lo = args.ph_lo, hi = args.ph_hi;
    int ph = 0;
    unsigned* barw = (unsigned*)ws;
    volatile LAS unsigned* bst = (volatile LAS unsigned*)(lds + LDS_BYTES - 64);
    if (tid < 2) bst[tid] = 0u;
    if (bid == 0) { for (int i = tid; i < XCD_BAR_WORDS; i += 512) __hip_atomic_store(barw + i, 0u, __ATOMIC_RELAXED, __HIP_MEMORY_SCOPE_AGENT); }
    __syncthreads();
    XcdBarrier xbar; xbar.bar = barw; xbar.x = 0; xbar.st = bst;
#ifndef REP_MASK
#define REP_MASK 0
#endif
#define NREP(k) (((REP_MASK >> (k)) & 1) ? 2 : 1)
#define RUN() (lo <= ph && ph < hi)
#define SEAM() do { if (lo <= ph && ph + 1 < hi) { if (ph == 0) { grid.sync(); xbar = xcd_barrier_post(barw, bst); } else { xcd_barrier(xbar); if ((REP_MASK >> 6) & 1) { xcd_barrier(xbar); } } } ++ph; } while (0)

    if (RUN()) for (int rep = 0; rep < NREP(0); ++rep) {
        if (rep) grid.sync();
        for (int r2 = 0; r2 < NREP(8); ++r2) ada_phase(lds, c_in, c_ctx, w_mod, b_mod, ada, G, bid);
        LAS float* scr = (LAS float*)(lds + wave * 16640);
        constexpr int I_GU = 16 * 88, I_D = 44 * 16, I_QKV = 16 * 48, I_O = 16 * 16;
        constexpr int NITEMS = 4 * I_GU + 4 * I_D + I_QKV + 2 * I_O;
        for (int r2 = 0; r2 < NREP(9); ++r2)
        for (int it = gw; it < NITEMS; it += NGW) {
            int q = it;
            if (q < 4 * I_GU) { const int f = q / I_GU; transpose_item(((f & 1) ? args.in[9] : args.in[7]) + (size_t)(f >> 1) * DM * NGU, DM, NGU, (bf16*)(ws + WS_WGU + f * WGU_SZ), true, scr, q % I_GU, lane); continue; } q -= 4 * I_GU;
            if (q < 4 * I_D) { const int f = q / I_D; transpose_item(((f & 1) ? args.in[10] : args.in[8]) + (size_t)(f >> 1) * DFF * DM, DFF, DM, (bf16*)(ws + WS_WD + f * WD_SZ), false, scr, q % I_D, lane); continue; } q -= 4 * I_D;
            if (q < I_QKV) { transpose_item(w_qkv, DM, 3072, WQKV, false, scr, q, lane); continue; } q -= I_QKV;
            if (q < I_O) { transpose_item(w_o, DM, DM, WO, false, scr, q, lane); continue; } q -= I_O;
            transpose_item(w_f, DM, DM, WF, false, scr, q, lane);
        }
        const int gt = vcu * 512 + tid, NGT = G * 512;
        for (int r2 = 0; r2 < NREP(10); ++r2)
        for (int i = gt; i < 2048 * 512; i += NGT) { const int k = i >> 9, j0 = (i & 511) * 8; const bool isS = j0 >= 2048; const int jj = j0 & 2047;
            float v[8];
#pragma unroll
            for (int e = 0; e < 8; ++e) { const int idx = (k * (jj + e)) & 2047; float sn, cs; sincospif((float)idx * (1.0f / 1024.0f), &sn, &cs); v[e] = (isS ? -sn : cs) * 0.02209708691f; }
            u32x4 w; w.x = pk2(v[0], v[1]); w.y = pk2(v[2], v[3]); w.z = pk2(v[4], v[5]); w.w = pk2(v[6], v[7]);
            *(u32x4*)(DFTS + (size_t)k * 4096 + j0) = w; }
        for (int i = gt; i < 512 * 32; i += NGT) { const int f = i >> 5, c0 = (i & 31) * 8; const bool isS = f >= 256; const int ff = f & 255;
            float v[8];
#pragma unroll
            for (int e = 0; e < 8; ++e) { const int idx = (ff * (c0 + e)) & 255; float sn, cs; sincospif((float)idx * (1.0f / 128.0f), &sn, &cs); v[e] = (isS ? sn : cs) * 0.0625f; }
            u32x4 w; w.x = pk2(v[0], v[1]); w.y = pk2(v[2], v[3]); w.z = pk2(v[4], v[5]); w.w = pk2(v[6], v[7]);
            *(u32x4*)(DFTC + (size_t)f * 256 + c0) = w; }
        for (int i = gt; i < 2048 * 32; i += NGT) { const int pos = i >> 5, axis = (i >> 4) & 1, p = i & 15;
            const float inv_freq = powf(10000.0f, -((float)p / 16.0f)); const float ang = (float)(axis ? (pos & 63) : (pos >> 6)) * inv_freq;
            float sn, cs; sincosf(ang, &sn, &cs); rope[i] = (f32x2){cs, sn}; }
        if (bid == 0 && wave == 0) {
            float p1 = wave_sum(lq1[lane] * lk1[lane]), p2 = wave_sum(lq2[lane] * lk2[lane]);
            float mq = fabsf(q_g[lane]), mk = fabsf(k_g[lane]);
#pragma unroll
            for (int o = 1; o < 64; o <<= 1) { mq = fmaxf(mq, __shfl_xor(mq, o)); mk = fmaxf(mk, __shfl_xor(mk, o)); }
            if (lane == 0) { scal[0] = expf(p1) - expf(p2) + 0.2f; scal[1] = 8.0f * mq * mk * 1.44269504089f; }
        }
    }
    SEAM();

    for (int fi = 0; fi < 4; ++fi) {
        const int layer = fi >> 1, which = fi & 1;
        const bool with_ctx = (fi == 0);
        const float* adaL = ada + (size_t)layer * 17 * NMOD;
        const float* xres = (fi == 0) ? x_in : out;
        if (RUN()) for (int rep = 0; rep < NREP(1); ++rep) norm_phase(xres, ctx_in, norm_g + (size_t)(layer * 3 + which * 2) * DM, adaL, which * 6, HB, with_ctx, vcu, NGW);
        SEAM();
        if (RUN()) for (int rep = 0; rep < NREP(2); ++rep) {
            if (rep) xcd_barrier(xbar);
            pg8::Gemm g{HB, (const bf16*)(ws + WS_WGU + fi * WGU_SZ), DM, DM, DM, 0u, 0u};
            pg8::Order S; S.init(with_ctx ? 144 : 128, 22, 1, with_ctx ? 0 : 1, 0, G, bid);
            pg8::EpiSwiglu E{BIG};
            pg8::gemm_phase<pg8::EpiSwiglu, pg8::Order>(lds, g, S, E);
        }
        SEAM();
        if (RUN()) {
            pg8::Gemm g{BIG, (const bf16*)(ws + WS_WD + fi * WD_SZ), DFF, DFF, DFF, 0u, 0u};
            pg8::Order S; S.init(with_ctx ? 144 : 128, 4, 1, with_ctx ? 0 : 1, 0, G, bid);
            pg8::EpiGateRes E{xres, ctx_in, out, Y1, adaL, which * 6 + 2, 0.5f};
            pg8::gemm_phase<pg8::EpiGateRes, pg8::Order>(lds, g, S, E);
        }
        SEAM();
        if (which == 0) {
            if (RUN()) for (int rep = 0; rep < NREP(7); ++rep) norm_phase(out, Y1, norm_g + (size_t)(layer * 3 + 1) * DM, adaL, 3, HB, layer == 0, vcu, NGW);
            SEAM();
            if (layer == 0) {
                if (RUN()) for (int rep = 0; rep < NREP(5); ++rep) {
                    if (rep) xcd_barrier(xbar);
                    for (int v = 0; v < 2; ++v) {
                        pg8::Gemm g; pg8::Order S; pg8::EpiBf16Split E;
                        if (v == 0) { g = pg8::Gemm{HB, WQKV, DM, DM, DM, 0u, 0u}; S.init(144, 8, 1, 0, 0, G, bid); E = pg8::EpiBf16Split{BIG, DM, DM, QK_STRIDE}; }
                        else { g = pg8::Gemm{WQKV + (size_t)2048 * DM, HB, DM, DM, DM, 0u, 0u}; S.init(4, 144, 1, 0, 0, G, bid); E = pg8::EpiBf16Split{BIG + 2 * QK_STRIDE, TOK, TOK, (size_t)1024 * TOK}; }
                        pg8::gemm_phase<pg8::EpiBf16Split, pg8::Order>(lds, g, S, E);
                    }
                }
                SEAM();
                if (RUN()) qknorm_phase(BIG, BIG + QK_STRIDE, q_g, k_g, rope, vcu, NGW);
                SEAM();
                if (RUN()) for (int rep = 0; rep < NREP(3); ++rep) attn_phase(lds, BIG, BIG + QK_STRIDE, BIG + 2 * QK_STRIDE, HB, sub_g, scal[0], scal[1], 0.8f, G, bid);
                SEAM();
            } else {
                if (RUN()) for (int rep = 0; rep < NREP(4); ++rep) {
                    if (rep) xcd_barrier(xbar);
                    pg8::Gemm g{DFTC, HB, 256, 256, DM, 0u, 512u};
                    pg8::Order S; S.init(2, 128, 4, 0, 1, G, bid);
                    pg8::EpiChan E{BIG};
                    pg8::gemm_phase<pg8::EpiChan, pg8::Order>(lds, g, S, E);
                }
                SEAM();
                if (RUN()) for (int rep = 0; rep < NREP(4); ++rep) {
                    if (rep) xcd_barrier(xbar);
                    pg8::Gemm g{DFTS, BIG, 4096, 4096, 4096, 0u, 0u};
                    pg8::Order S; S.init(8, 64, 1, 0, 0, G, bid);
                    pg8::EpiBf16Split E{HB + (size_t)CTX * DM, DM, DM, (size_t)TOK * DM};
                    pg8::gemm_phase<pg8::EpiBf16Split, pg8::Order>(lds, g, S, E);
                }
                SEAM();
            }
            if (RUN()) {
                pg8::Gemm g{HB, layer == 0 ? WO : WF, DM, DM, DM, 0u, 0u};
                pg8::Order S; S.init(128, 4, 1, 1, 0, G, bid);
                pg8::EpiGateRes E{out, ctx_in, out, Y1, adaL, 5, 1.0f};
                pg8::gemm_phase<pg8::EpiGateRes, pg8::Order>(lds, g, S, E);
            }
            SEAM();
        }
    }
#undef RUN
#undef SEAM
}

extern "C" void kernel_launch(void* const* d_in, const int* in_sizes, int n_in, void* d_out, int out_size, void* d_ws, size_t ws_size, hipStream_t stream) {
    static int grid = 0;
    if (grid == 0) {
        if (n_in != 21 || ws_size < WS_END) { fprintf(stderr, "kernel_launch: unexpected n_in %d / ws %zu\n", n_in, ws_size); grid = -1; return; }
        int dev = 0, cus = 0, per_cu = 0;
        hipGetDevice(&dev); hipDeviceGetAttribute(&cus, hipDeviceAttributeMultiprocessorCount, dev);
        if (hipFuncSetAttribute((const void*)fwd_kernel, hipFuncAttributeMaxDynamicSharedMemorySize, LDS_BYTES) != hipSuccess) { fprintf(stderr, "kernel_launch: hipFuncSetAttribute failed\n"); grid = -1; return; }
        if (hipOccupancyMaxActiveBlocksPerMultiprocessor(&per_cu, (const void*)fwd_kernel, 512, LDS_BYTES) != hipSuccess || per_cu < 1) { fprintf(stderr, "kernel_launch: occupancy query gave %d\n", per_cu); per_cu = 1; }
        (void)hipGetLastError();
        grid = cus * per_cu;
    }
    if (grid < 0) return;
    Args a{};
    for (int i = 0; i < 21; ++i) a.in[i] = (const float*)d_in[i];
    a.out = (float*)d_out; a.ws = (unsigned char*)d_ws; a.ph_lo = 0; a.ph_hi = 1000;
    void* kargs[] = {&a};
    hipError_t e = hipLaunchCooperativeKernel((const void*)fwd_kernel, dim3(grid), dim3(512), kargs, LDS_BYTES, stream);
    if (e != hipSuccess) fprintf(stderr, "cooperative launch failed: %s (grid %d)\n", hipGetErrorString(e), grid);
}
```

```cpp
#include <hip/hip_runtime.h>
#include <hip/hip_cooperative_groups.h>
#include <cstdio>
#include <cstdint>
namespace cg = cooperative_groups;

#define LAS __attribute__((address_space(3)))
typedef unsigned short bf16;
typedef short bf16x8 __attribute__((ext_vector_type(8)));
typedef float f32x4 __attribute__((ext_vector_type(4)));
typedef float f32x2 __attribute__((ext_vector_type(2)));
typedef float f32x16 __attribute__((ext_vector_type(16)));
typedef unsigned u32x4 __attribute__((ext_vector_type(4)));
typedef unsigned u32x2 __attribute__((ext_vector_type(2)));
typedef __bf16 bf16x2_t __attribute__((ext_vector_type(2)));

__device__ __forceinline__ unsigned pk2(float lo, float hi) { f32x2 v = {lo, hi}; bf16x2_t b = __builtin_convertvector(v, bf16x2_t); return __builtin_bit_cast(unsigned, b); }
__device__ __forceinline__ float bf_lo(unsigned w) { return __uint_as_float(w << 16); }
__device__ __forceinline__ float bf_hi(unsigned w) { return __uint_as_float(w & 0xffff0000u); }
__device__ __forceinline__ int lane_id_v() { int l; asm volatile("v_mbcnt_lo_u32_b32 %0, -1, 0\n\tv_mbcnt_hi_u32_b32 %0, -1, %0" : "=v"(l)); return l; }
template <int M> __device__ __forceinline__ float shx(float v) { return __builtin_bit_cast(float, __builtin_amdgcn_ds_swizzle(__builtin_bit_cast(int, v), (M << 10) | 0x1f)); }
__device__ __forceinline__ float add_x32(float v) { const unsigned u = __builtin_bit_cast(unsigned, v); auto rr = __builtin_amdgcn_permlane32_swap(u, u, false, false); return __uint_as_float(rr[0]) + __uint_as_float(rr[1]); }
__device__ __forceinline__ float wave_sum(float v) { v += shx<1>(v); v += shx<2>(v); v += shx<4>(v); v += shx<8>(v); v += shx<16>(v); return add_x32(v); }

constexpr int DM = 1024, NB = 16, SEQ = 2048, CTX = 256, TOK = 2304, MC = NB * TOK  , MX = NB * SEQ  , DFF = 2816, NGU = 5632, NMOD = 9216;
constexpr float EPS = 1e-6f;
constexpr float QSCALE = 0.125f * 1.44269504089f;
constexpr size_t MiB = 1u << 20;
constexpr size_t WS_ADA = 1 * MiB;
constexpr size_t WS_SCAL = 3 * MiB;
constexpr size_t WS_ROPE = 3 * MiB + 4096;
constexpr size_t WS_H1024 = 3 * MiB + 640 * 1024;
constexpr size_t WS_T = 3 * MiB + 768 * 1024;
constexpr size_t WS_WGU = 4 * MiB;
constexpr size_t WS_WD = 48 * MiB;
constexpr size_t WS_WQKV = 70 * MiB;
constexpr size_t WS_WO = 76 * MiB;
constexpr size_t WS_WF = 78 * MiB;
constexpr size_t WS_DFTS = 80 * MiB;
constexpr size_t WS_DFTC = 96 * MiB;
constexpr size_t WS_Y1 = 98 * MiB;
constexpr size_t WS_HB = 114 * MiB;
constexpr size_t WS_BIG = 186 * MiB;
constexpr size_t WS_END = 402 * MiB;
constexpr size_t WGU_SZ = (size_t)NGU * DM * 2, WD_SZ = (size_t)DM * DFF * 2;
constexpr size_t QK_STRIDE = (size_t)MC * DM;
constexpr int LDS_BYTES = 147456;

struct Args { const float* in[21]; float* out; unsigned char* ws; int ph_lo, ph_hi; };
typedef const __attribute__((address_space(4))) Args* KArgs;
#define KA() ({ KArgs _p = (KArgs)__builtin_amdgcn_kernarg_segment_ptr(); asm volatile("" : "+s"(_p)); _p; })
#define P_WS   (ka->ws)
#define P_OUT  (ka->out)
#define P_ADA  ((float*)(ka->ws + WS_ADA))
#define P_SCAL ((float*)(ka->ws + WS_SCAL))
#define P_ROPE ((f32x2*)(ka->ws + WS_ROPE))
#define P_WQKV ((bf16*)(ka->ws + WS_WQKV))
#define P_WO   ((bf16*)(ka->ws + WS_WO))
#define P_WF   ((bf16*)(ka->ws + WS_WF))
#define P_DFTS ((bf16*)(ka->ws + WS_DFTS))
#define P_DFTC ((bf16*)(ka->ws + WS_DFTC))
#define P_Y1   ((float*)(ka->ws + WS_Y1))
#define P_HB   ((bf16*)(ka->ws + WS_HB))
#define P_BIG  ((bf16*)(ka->ws + WS_BIG))

namespace pg8 {
#define PG8_LAS __attribute__((address_space(3)))
typedef unsigned short bf16_t;
constexpr int BM = 256, BK = 64, HALF = 128, HTB = HALF * BK * 2, STAGE_BYTES = 8 * HTB, NXCD = 8, WGM = 8;

__host__ __device__ __forceinline__ int lds_byte(int r, int c) { const int st = (r >> 4) * 2 + (c >> 5), rr = r & 15, cc = c & 31, ob = rr * 64 + cc * 2; return st * 1024 + (ob ^ (((ob >> 9) & 1) << 5)); }
__host__ __device__ __forceinline__ void stage_rc(int b, int& R, int& C) { const int st = b / 1024, sb = b % 1024, swz = sb ^ (((sb >> 9) & 1) << 5); R = (st >> 1) * 16 + swz / 64; C = (st & 1) * 32 + (swz % 64) / 2; }
__host__ __device__ __forceinline__ int perm32(int rho) { const int n = rho >> 4, i = rho & 15; return 8 * (i >> 2) + 4 * n + (i & 3); }

struct Unit { int pm, pn, g; };
struct Gemm { const bf16_t* A; const bf16_t* Bt; int K, lda, ldb; unsigned gstepA, gstepB; };

struct Order {
    int nM, nN, per, total, G, c, remapM, remapN, chan;
    __device__ __forceinline__ void init(int nM_, int nN_, int nG_, int remapM_, int remapN_, int G_, int c_) { asm volatile("" : "+s"(c_), "+s"(G_));
        nM = nM_; nN = nN_; per = nM_ * nN_; total = per * nG_; remapM = remapM_; remapN = remapN_; G = G_; c = c_; chan = 0; }
    __device__ __forceinline__ bool next(int i, Unit& u) const {
        const long L = (long)i * G + c; if (L >= total) return false;
        int wgid = (int)L; { const int q = total / NXCD, r = total % NXCD, xcd = wgid % NXCD, off = wgid / NXCD; wgid = (xcd < r ? xcd * (q + 1) : r * (q + 1) + (xcd - r) * q) + off; }
        u.g = wgid / per; const int w = wgid % per;
        const int nig = WGM * nN, gid = w / nig, fm = gid * WGM, gsz = (nM - fm) < WGM ? (nM - fm) : WGM;
        int pm = fm + ((w % nig) % gsz), pn = (w % nig) / gsz;
        if (remapM) pm = (pm >> 3) * 9 + 1 + (pm & 7);
        if (remapN) pn = (pn >> 3) * 9 + 1 + (pn & 7);
        if (chan) pm = ((pn % 9) - 1) >> 2;
        u.pm = pm; u.pn = pn; return true;
    }
    __device__ __forceinline__ void a_ready(const Unit&) const {}
    __device__ __forceinline__ void done(const Unit&) const {}
};

struct EpiBf16Split {
    static constexpr bool PERM = true, AFTER_DRAIN = false;
    bf16_t* O; int ldc; int split_cols; size_t split_stride;
    __device__ __forceinline__ void operator()(const f32x4 (&acc)[2][2][4][2], const Unit& u, int wr, int wc, int fr, int fq) const {
        const int row0 = u.pm * BM + wr * 64 + fr; int colt = u.pn * BM; bf16_t* base = O;
        { const int t = colt / split_cols; base += (size_t)t * split_stride; colt -= t * split_cols; }
        const int col0 = colt + wc * 32 + 8 * fq;
#pragma unroll
        for (int ai = 0; ai < 2; ++ai)
#pragma unroll
            for (int m = 0; m < 4; ++m) { bf16_t* rowp = base + (size_t)(row0 + ai * HALF + m * 16) * ldc + col0;
#pragma unroll
                for (int bj = 0; bj < 2; ++bj) { const f32x4 v0 = acc[ai][bj][m][0], v1 = acc[ai][bj][m][1];
                    u32x4 w; w.x = pk2(v0[0], v0[1]); w.y = pk2(v0[2], v0[3]); w.z = pk2(v1[0], v1[1]); w.w = pk2(v1[2], v1[3]);
                    *(u32x4*)(rowp + bj * HALF) = w; } }
    }
};
struct EpiSwiglu {
    static constexpr bool PERM = true, AFTER_DRAIN = false;
    bf16_t* O;
    __device__ __forceinline__ void operator()(const f32x4 (&acc)[2][2][4][2], const Unit& u, int wr, int wc, int fr, int fq) const {
        const int row0 = u.pm * BM + wr * 64 + fr, col0 = u.pn * HALF + wc * 32 + 8 * fq;
#pragma unroll
        for (int ai = 0; ai < 2; ++ai)
#pragma unroll
            for (int m = 0; m < 4; ++m) { bf16_t* rowp = O + (size_t)(row0 + ai * HALF + m * 16) * 2816 + col0;
                float v[8];
#pragma unroll
                for (int n = 0; n < 2; ++n)
#pragma unroll
                    for (int j = 0; j < 4; ++j) { const float g = acc[ai][0][m][n][j], uu = acc[ai][1][m][n][j];
                        v[4 * n + j] = g * uu * __builtin_amdgcn_rcpf(1.0f + __builtin_amdgcn_exp2f(-1.44269504089f * g)); }
                u32x4 w; w.x = pk2(v[0], v[1]); w.y = pk2(v[2], v[3]); w.z = pk2(v[4], v[5]); w.w = pk2(v[6], v[7]);
                *(u32x4*)rowp = w; }
    }
};
struct EpiGateRes {
    static constexpr bool PERM = false, AFTER_DRAIN = false;
    int first; int layer; int kg; float coef;
    __device__ __forceinline__ void operator()(const f32x4 (&acc)[2][2][4][2], const Unit& u, int wr, int wc, int fr, int fq) const {
        KArgs ka = KA();
        const int b = u.pm / 9, j = u.pm % 9; const float* rb; float* ob; int s;
        if (j == 0) { const size_t off = (size_t)b * 256 * 1024; rb = ka->in[2] + off; ob = P_Y1 + off; s = 16; }
        else { const size_t off = ((size_t)b * 2048 + (size_t)(j - 1) * 256) * 1024; rb = (first ? ka->in[0] : (const float*)P_OUT) + off; ob = P_OUT + off; s = b; }
        const float* gate = P_ADA + (size_t)layer * 17 * NMOD + (size_t)(s * 9 + kg) * 1024;
        const int row0 = wr * 64 + fr, col0 = u.pn * BM + wc * 32 + 4 * fq;
        f32x4 gv[2][2];
#pragma unroll
        for (int bj = 0; bj < 2; ++bj)
#pragma unroll
            for (int n = 0; n < 2; ++n) gv[bj][n] = *(const f32x4*)(gate + col0 + bj * HALF + n * 16) * coef;
#pragma unroll
        for (int ai = 0; ai < 2; ++ai)
#pragma unroll
            for (int m = 0; m < 4; ++m) { const size_t roff = (size_t)(row0 + ai * HALF + m * 16) * 1024 + col0;
#pragma unroll
                for (int bj = 0; bj < 2; ++bj)
#pragma unroll
                    for (int n = 0; n < 2; ++n) { const f32x4 r = *(const f32x4*)(rb + roff + bj * HALF + n * 16);
                        *(f32x4*)(ob + roff + bj * HALF + n * 16) = r + gv[bj][n] * acc[ai][bj][m][n]; } }
    }
};
struct EpiChan {
    static constexpr bool PERM = true, AFTER_DRAIN = false;
    bf16_t* XT;
    __device__ __forceinline__ void operator()(const f32x4 (&acc)[2][2][4][2], const Unit& u, int wr, int wc, int fr, int fq) const {
        const int b = u.pn / 9, jt = u.pn % 9 - 1;
        bf16_t* base = XT + (size_t)(b * 1024 + u.g * 256) * 2048 + jt * 256;
        const int row0 = wr * 64 + fr, col0 = wc * 32 + 8 * fq;
#pragma unroll
        for (int ai = 0; ai < 2; ++ai)
#pragma unroll
            for (int m = 0; m < 4; ++m) { bf16_t* rowp = base + (size_t)(row0 + ai * HALF + m * 16) * 2048 + col0;
#pragma unroll
                for (int bj = 0; bj < 2; ++bj) { const f32x4 v0 = acc[ai][bj][m][0], v1 = acc[ai][bj][m][1];
                    u32x4 w; w.x = pk2(v0[0], v0[1]); w.y = pk2(v0[2], v0[3]); w.z = pk2(v1[0], v1[1]); w.w = pk2(v1[2], v1[3]);
                    *(u32x4*)(rowp + bj * HALF) = w; } }
    }
};
struct EpiSeq {
    static constexpr bool PERM = true, AFTER_DRAIN = false;
    bf16_t* O; const float* T;
    __device__ __forceinline__ void operator()(const f32x4 (&acc)[2][2][4][2], const Unit& u, int wr, int wc, int fr, int fq) const {
        const int row0 = u.pm * BM + wr * 64 + fr; const int colt = u.pn * BM; const int b = colt >> 10;
        bf16_t* base = O + (size_t)b * 2304 * 1024;
        const int col0 = (colt & 1023) + wc * 32 + 8 * fq;
        const float sg = (fr & 1) ? -1.0f : 1.0f;
        f32x4 tv[2][2];
#pragma unroll
        for (int bj = 0; bj < 2; ++bj)
#pragma unroll
            for (int n = 0; n < 2; ++n) tv[bj][n] = *(const f32x4*)(T + colt + wc * 32 + 8 * fq + bj * HALF + 4 * n) * sg;
#pragma unroll
        for (int ai = 0; ai < 2; ++ai)
#pragma unroll
            for (int m = 0; m < 4; ++m) { bf16_t* rowp = base + (size_t)(row0 + ai * HALF + m * 16) * 1024 + col0;
#pragma unroll
                for (int bj = 0; bj < 2; ++bj) { const f32x4 v0 = acc[ai][bj][m][0] + tv[bj][0], v1 = acc[ai][bj][m][1] + tv[bj][1];
                    u32x4 w; w.x = pk2(v0[0], v0[1]); w.y = pk2(v0[2], v0[3]); w.z = pk2(v1[0], v1[1]); w.w = pk2(v1[2], v1[3]);
                    *(u32x4*)(rowp + bj * HALF) = w; } }
    }
};

template <class Epi, class Sched, bool ALIGN_EPI = true>
__device__ __forceinline__ void gemm_phase(PG8_LAS unsigned char* lds, const Gemm g, const Sched& S, const Epi& E, int wv) {
    const int tid = wv * 64 + lane_id_v();
    const int wid = __builtin_amdgcn_readfirstlane(tid >> 6), lane = tid & 63, wr = wid >> 2, wc = wid & 3, fr = lane & 15, fq = lane >> 4;
    int K = g.K, lda = g.lda, ldb = g.ldb; asm volatile("" : "+s"(K), "+s"(lda), "+s"(ldb));
    const int nt = K / BK;
    unsigned voffA[2], voffB[2];
#pragma unroll
    for (int i = 0; i < 2; ++i) { int R, C; stage_rc(tid * 16 + i * 8192, R, C); const int Rb = Epi::PERM ? ((R & ~31) + perm32(R & 31)) : R;
        voffA[i] = (unsigned)(R * lda + C) * 2u; voffB[i] = (unsigned)(Rb * ldb + C) * 2u; }
    const size_t kstep = (size_t)(BK * 2);
    const size_t hstepA = (size_t)HALF * lda * 2, hstepB = (size_t)HALF * ldb * 2;
    const size_t tstepA = 2 * hstepA, tstepB = 2 * hstepB;
    const unsigned ldsw = (unsigned)wid * 1024u;
    const int aoff = lds_byte(wr * 64 + fr, fq * 8), boff = lds_byte(wc * 32 + fr, fq * 8);
#define PG8_SA(b, h) (((b) * 2 + (h)) * HTB)
#define PG8_SB(b, h) ((4 + (b) * 2 + (h)) * HTB)
#define PG8_STAGE(bufoff, gbase, voff) do { _Pragma("unroll") for (int _i = 0; _i < 2; ++_i) \
        __builtin_amdgcn_global_load_lds((const unsigned*)((const char*)(gbase) + (voff)[_i]), (PG8_LAS unsigned*)(lds + (bufoff) + ldsw + _i * 8192), 16, 0, 0); } while (0)
#define PG8_LDA(dst, b, h) do { _Pragma("unroll") for (int m = 0; m < 4; ++m) _Pragma("unroll") for (int k = 0; k < 2; ++k) dst[m][k] = *(const PG8_LAS bf16x8*)(lds + PG8_SA(b, h) + aoff + m * 2048 + k * 1024); } while (0)
#define PG8_LDB(dst, b, h) do { _Pragma("unroll") for (int n = 0; n < 2; ++n) _Pragma("unroll") for (int k = 0; k < 2; ++k) dst[n][k] = *(const PG8_LAS bf16x8*)(lds + PG8_SB(b, h) + boff + n * 2048 + k * 1024); } while (0)
#define PG8_MMA(ai, bj, At, Bt) do { __builtin_amdgcn_s_setprio(1); _Pragma("unroll") for (int m = 0; m < 4; ++m) _Pragma("unroll") for (int n = 0; n < 2; ++n) _Pragma("unroll") for (int k = 0; k < 2; ++k) \
        acc[ai][bj][m][n] = __builtin_amdgcn_mfma_f32_16x16x32_bf16(Bt[n][k], At[m][k], acc[ai][bj][m][n], 0, 0, 0); __builtin_amdgcn_s_setprio(0); } while (0)
#define PG8_WAIT_V(n) asm volatile("s_waitcnt vmcnt(" #n ")" ::: "memory")
#define PG8_WAIT_L(n) asm volatile("s_waitcnt lgkmcnt(" #n ")" ::: "memory")
#define PG8_BAR __builtin_amdgcn_s_barrier()
#define PG8_SCHED __builtin_amdgcn_sched_barrier(0)
    Unit cur, nxt; int ui = 0;
    if (!S.next(0, cur)) return;
    f32x4 acc[2][2][4][2];
#pragma unroll
    for (int a = 0; a < 2; ++a)
#pragma unroll
        for (int b = 0; b < 2; ++b)
#pragma unroll
            for (int m = 0; m < 4; ++m)
#pragma unroll
                for (int n = 0; n < 2; ++n) acc[a][b][m][n] = (f32x4){0.f, 0.f, 0.f, 0.f};
    bf16x8 At[4][2], B0[2][2], B1[2][2];
    const char* cA = (const char*)g.A + (size_t)cur.pm * tstepA + (size_t)cur.g * g.gstepA; const char* cB = (const char*)g.Bt + (size_t)cur.pn * tstepB + (size_t)cur.g * g.gstepB;
    S.a_ready(cur);
    PG8_STAGE(PG8_SB(0, 0), cB, voffB); PG8_STAGE(PG8_SB(0, 1), cB + hstepB, voffB); PG8_STAGE(PG8_SA(0, 0), cA, voffA); PG8_STAGE(PG8_SA(0, 1), cA + hstepA, voffA);
    if (wr == 1) PG8_BAR;
    PG8_WAIT_V(2); PG8_BAR;
    PG8_STAGE(PG8_SB(1, 0), cB + kstep, voffB); PG8_STAGE(PG8_SA(1, 0), cA + kstep, voffA); PG8_STAGE(PG8_SB(1, 1), cB + hstepB + kstep, voffB);
    PG8_WAIT_V(6); PG8_BAR;
    for (;;) {
        const bool has_next = S.next(ui + 1, nxt);
        const char* nA = has_next ? (const char*)g.A + (size_t)nxt.pm * tstepA + (size_t)nxt.g * g.gstepA : cA; const char* nB = has_next ? (const char*)g.Bt + (size_t)nxt.pn * tstepB + (size_t)nxt.g * g.gstepB : cB;
        for (int t = 0; t < nt; t += 2) {
            const bool last = (t == nt - 2);
            const char* a1 = cA + (size_t)(t + 1) * kstep;
            const char* a2 = last ? nA : cA + (size_t)(t + 2) * kstep; const char* b2 = last ? nB : cB + (size_t)(t + 2) * kstep;
            const char* a3 = a2 + kstep; const char* b3 = b2 + kstep;
            if (last && has_next) S.a_ready(nxt);
            PG8_LDB(B0, 0, 0); PG8_LDB(B1, 0, 1); PG8_SCHED; PG8_LDA(At, 0, 0); PG8_STAGE(PG8_SA(1, 1), a1 + hstepA, voffA);
            PG8_WAIT_V(8); PG8_WAIT_L(0); PG8_BAR; PG8_MMA(0, 0, At, B0); PG8_MMA(0, 1, At, B1); PG8_BAR; PG8_SCHED;
            PG8_LDA(At, 0, 1); PG8_STAGE(PG8_SB(0, 0), b2, voffB); PG8_STAGE(PG8_SB(0, 1), b2 + hstepB, voffB); PG8_STAGE(PG8_SA(0, 0), a2, voffA);
            PG8_WAIT_V(8); PG8_WAIT_L(0); PG8_BAR; PG8_MMA(1, 0, At, B0); PG8_MMA(1, 1, At, B1); PG8_BAR; PG8_SCHED;
            PG8_LDB(B0, 1, 0); PG8_LDB(B1, 1, 1); PG8_SCHED; PG8_LDA(At, 1, 0); PG8_STAGE(PG8_SA(0, 1), a2 + hstepA, voffA);
            PG8_WAIT_V(8); PG8_WAIT_L(0); PG8_BAR; PG8_MMA(0, 0, At, B0); PG8_MMA(0, 1, At, B1); PG8_BAR; PG8_SCHED;
            PG8_LDA(At, 1, 1); PG8_STAGE(PG8_SB(1, 0), b3, voffB); PG8_STAGE(PG8_SB(1, 1), b3 + hstepB, voffB); PG8_STAGE(PG8_SA(1, 0), a3, voffA);
            PG8_WAIT_V(8); PG8_WAIT_L(0); PG8_BAR; PG8_MMA(1, 0, At, B0); PG8_MMA(1, 1, At, B1); PG8_BAR; PG8_SCHED;
        }
        if constexpr (ALIGN_EPI) { if (wr == 0) PG8_BAR; }
        E(acc, cur, wr, wc, fr, fq); S.done(cur);
        if (!has_next) break;
#pragma unroll
        for (int a = 0; a < 2; ++a)
#pragma unroll
            for (int b = 0; b < 2; ++b)
#pragma unroll
                for (int m = 0; m < 4; ++m)
#pragma unroll
                    for (int n = 0; n < 2; ++n) acc[a][b][m][n] = (f32x4){0.f, 0.f, 0.f, 0.f};
        cur = nxt; cA = nA; cB = nB; ++ui;
        if constexpr (ALIGN_EPI) { if (wr == 1) PG8_BAR; }
    }
    PG8_WAIT_V(0);
    if constexpr (!ALIGN_EPI) { if (wr == 0) PG8_BAR; }
    PG8_BAR;
#undef PG8_SA
#undef PG8_SB
#undef PG8_STAGE
#undef PG8_LDA
#undef PG8_LDB
#undef PG8_MMA
#undef PG8_WAIT_V
#undef PG8_WAIT_L
#undef PG8_BAR
#undef PG8_SCHED
}
}


#define XB_TMO      128
#define XB_XCNT(j)  (256  + 64 * (j))
#define XB_XSUB(j)  (1280 + 64 * (j))
#define XB_XGEN(j)  (2304 + 64 * (j))
#define XB_TOP      3328
#define XB_TOPGEN   3392
#define XCD_BAR_WORDS 3456
#define XB_SPIN_CAP (1u << 18)
__device__ __forceinline__ unsigned xb_ld(unsigned* p)              { return __hip_atomic_load(p, __ATOMIC_RELAXED, __HIP_MEMORY_SCOPE_AGENT); }
__device__ __forceinline__ unsigned xb_add(unsigned* p, unsigned v) { return __hip_atomic_fetch_add(p, v, __ATOMIC_RELAXED, __HIP_MEMORY_SCOPE_AGENT); }
__device__ __forceinline__ unsigned xb_xcc_id() { return (unsigned)__builtin_amdgcn_s_getreg((3 << 11) | 20) & 0xFu; }
#define XB_SPIN(cond, bar) do { unsigned _sp = 0; while (cond) { __builtin_amdgcn_s_sleep(1); \
    if ((++_sp & 255u) == 0u) { if (xb_ld(&(bar)[XB_TMO])) break; if (_sp > XB_SPIN_CAP) { atomicAdd(&(bar)[XB_TMO], 1u); break; } } } } while (0)
struct XcdBarrier { unsigned* bar; unsigned x; volatile LAS unsigned* st; };
__device__ __forceinline__ XcdBarrier xcd_barrier_post(unsigned* bar, volatile LAS unsigned* st, bool t0) {
    XcdBarrier b; b.bar = bar; b.x = xb_xcc_id(); b.st = st;
    if (t0) (void)xb_add(&bar[XB_XCNT(b.x)], 1u);
    return b;
}
__device__ __forceinline__ void xcd_barrier_complete(unsigned* bar, unsigned x, unsigned& nloc, unsigned& nx) {
    const unsigned G = gridDim.x * gridDim.y * gridDim.z;
    unsigned sum, cnt, mine, sp = 0u;
    for (;;) {
        sum = 0u; cnt = 0u; mine = 0u;
#pragma unroll
        for (unsigned j = 0; j < 16; ++j) { const unsigned c = xb_ld(&bar[XB_XCNT(j)]); sum += c; cnt += (c > 0u) ? 1u : 0u; mine = (j == x) ? c : mine; }
        if (sum == G) break;
        __builtin_amdgcn_s_sleep(1);
        if ((++sp & 255u) == 0u) { if (xb_ld(&bar[XB_TMO])) break; if (sp > XB_SPIN_CAP) { atomicAdd(&bar[XB_TMO], 1u); break; } }
    }
    nloc = mine > 0u ? mine : 1u; nx = cnt > 0u ? cnt : 1u;
}
__device__ __forceinline__ void xcd_barrier(const XcdBarrier& b, bool t0) {
    asm volatile("s_waitcnt vmcnt(0)" ::: "memory");
    __syncthreads();
    if (t0) {
        unsigned* bar = b.bar;
        __builtin_amdgcn_s_waitcnt(0);
        unsigned nloc = b.st[0], nx = b.st[1];
        if (nloc == 0u) { xcd_barrier_complete(bar, b.x, nloc, nx); b.st[0] = nloc; b.st[1] = nx; }
        const unsigned old = xb_add(&bar[XB_XSUB(b.x)], 1u);
        const unsigned gen = old / nloc;
        if (old + 1u == (gen + 1u) * nloc) {
            __builtin_amdgcn_fence(__ATOMIC_RELEASE, "agent");
            asm volatile("s_waitcnt vmcnt(0)" ::: "memory");
            const unsigned og = xb_add(&bar[XB_TOP], 1u);
            const unsigned tg = og / nx;
            if (og + 1u == (tg + 1u) * nx) xb_add(&bar[XB_TOPGEN], 1u);
            else XB_SPIN(xb_ld(&bar[XB_TOPGEN]) == tg, bar);
            __builtin_amdgcn_fence(__ATOMIC_ACQUIRE, "agent");
            xb_add(&bar[XB_XGEN(b.x)], 1u);
            asm volatile("s_waitcnt vmcnt(0)" ::: "memory");
        } else {
            XB_SPIN(xb_ld(&bar[XB_XGEN(b.x)]) == gen, bar);
            __builtin_amdgcn_fence(__ATOMIC_ACQUIRE, "agent");
            asm volatile("s_waitcnt vmcnt(0)" ::: "memory");
        }
    }
    __syncthreads();
}

__device__ __forceinline__ void transpose_item(const float* W, int K, int N, bf16* WT, bool gu, LAS float* scr, int item, int lane) {
    const int nblk = N / 64, kb = item / nblk, nb = item % nblk, k0 = 64 * kb, n0 = 64 * nb;
    int r0 = n0;
    if (gu) { const int jj = (n0 < DFF) ? n0 : n0 - DFF; r0 = (jj >> 7) * 256 + (jj & 127) + ((n0 < DFF) ? 0 : 128); }
    const int n4 = lane & 15, kr = lane >> 4;
    const float* wp = W + (size_t)(k0 + kr) * N + n0 + 4 * n4;
    f32x4 v[16];
#pragma unroll
    for (int i = 0; i < 16; ++i) v[i] = *(const f32x4*)(wp + (size_t)(4 * i) * N);
#pragma unroll
    for (int i = 0; i < 16; ++i) { LAS float* d = scr + (4 * i + kr) * 65 + 4 * n4; d[0] = v[i].x; d[1] = v[i].y; d[2] = v[i].z; d[3] = v[i].w; }
    asm volatile("s_waitcnt lgkmcnt(0)" ::: "memory");
    const int c = lane & 7;
#pragma unroll
    for (int j = 0; j < 8; ++j) { const int n = (lane >> 3) + 8 * j; const LAS float* q = scr + (8 * c) * 65 + n;
        u32x4 o; o.x = pk2(q[0 * 65], q[1 * 65]); o.y = pk2(q[2 * 65], q[3 * 65]); o.z = pk2(q[4 * 65], q[5 * 65]); o.w = pk2(q[6 * 65], q[7 * 65]);
        *(u32x4*)(WT + (size_t)(r0 + n) * K + k0 + 8 * c) = o; }
    asm volatile("s_waitcnt lgkmcnt(0)" ::: "memory");
}


__device__ __forceinline__ void norm_phase(const float* xsrc, const float* ysrc, const float* gvec, const float* ada, int kshift, bf16* hb, bool with_ctx, int vcu, int NGW, int wv) {
    const int tid = wv * 64 + lane_id_v(); asm volatile("" : "+s"(vcu), "+s"(NGW));
    const int lane = tid & 63, gw = vcu * 8 + __builtin_amdgcn_readfirstlane(tid >> 6);
    const int nrows = with_ctx ? MC : MX;
    for (int i = gw; i < nrows; i += NGW) {
        int b, j;
        if (with_ctx) { b = i / TOK; j = i % TOK; } else { b = i >> 11; j = 256 + (i & 2047); }
        const float* src; int s;
        if (j < CTX) { src = ysrc + ((size_t)b * CTX + j) * DM; s = 16; } else { src = xsrc + ((size_t)b * SEQ + (j - CTX)) * DM; s = b; }
        const f32x4* xr = (const f32x4*)src + lane;
        f32x4 v[4]; float ss = 0.f;
#pragma unroll
        for (int q = 0; q < 4; ++q) { v[q] = xr[64 * q]; ss += (v[q].x * v[q].x + v[q].y * v[q].y) + (v[q].z * v[q].z + v[q].w * v[q].w); }
        const float rstd = rsqrtf(wave_sum(ss) * (1.f / DM) + EPS);
        const f32x4* gp = (const f32x4*)gvec + lane; const f32x4* shp = (const f32x4*)(ada + (size_t)(s * 9 + kshift) * DM) + lane; const f32x4* scp = shp + DM / 4;
        u32x2* o8 = (u32x2*)(hb + ((size_t)b * TOK + j) * DM) + lane;
#pragma unroll
        for (int q = 0; q < 4; ++q) { const f32x4 gg = gp[64 * q], sh = shp[64 * q], sc = scp[64 * q];
            const f32x4 o = v[q] * rstd * gg * (sc + 1.0f) + sh;
            u32x2 w; w.x = pk2(o.x, o.y); w.y = pk2(o.z, o.w); o8[64 * q] = w; }
    }
}

__device__ __forceinline__ void norm_fourier_phase(const float* xsrc, const float* gvec, const float* ada, bf16* hb, float* h1024, int vcu, int NGW, int wv) {
    const int tid = wv * 64 + lane_id_v(); asm volatile("" : "+s"(vcu), "+s"(NGW));
    const int lane = tid & 63, gw = vcu * 8 + __builtin_amdgcn_readfirstlane(tid >> 6);
    for (int i = gw; i < NB * 1024; i += NGW) {
        const int b = i >> 10, p = i & 1023, p2 = p ? (SEQ - p) : (SEQ / 2);
        const f32x4* xa = (const f32x4*)(xsrc + ((size_t)b * SEQ + p) * DM) + lane; const f32x4* xb = (const f32x4*)(xsrc + ((size_t)b * SEQ + p2) * DM) + lane;
        f32x4 va[4], vb[4]; float sa = 0.f, sb = 0.f;
#pragma unroll
        for (int q = 0; q < 4; ++q) { va[q] = xa[64 * q]; vb[q] = xb[64 * q];
            sa += (va[q].x * va[q].x + va[q].y * va[q].y) + (va[q].z * va[q].z + va[q].w * va[q].w); sb += (vb[q].x * vb[q].x + vb[q].y * vb[q].y) + (vb[q].z * vb[q].z + vb[q].w * vb[q].w); }
        const float ra = rsqrtf(wave_sum(sa) * (1.f / DM) + EPS), rb = rsqrtf(wave_sum(sb) * (1.f / DM) + EPS);
        const f32x4* gp = (const f32x4*)gvec + lane; const f32x4* shp = (const f32x4*)(ada + (size_t)(b * 9 + 3) * DM) + lane; const f32x4* scp = shp + DM / 4;
        u32x2* oe = (u32x2*)(hb + ((size_t)b * TOK + CTX + p) * DM) + lane; u32x2* oo = (u32x2*)(hb + ((size_t)b * TOK + CTX + 1024 + p) * DM) + lane;
        f32x4* hs = (f32x4*)(h1024 + (size_t)b * DM) + lane;
#pragma unroll
        for (int q = 0; q < 4; ++q) { const f32x4 gg = gp[64 * q] * (scp[64 * q] + 1.0f), sh = shp[64 * q];
            const f32x4 ha = va[q] * ra * gg + sh, hbv = vb[q] * rb * gg + sh;
            f32x4 e, o;
            if (p) { e = ha + hbv; o = ha - hbv; } else { e = ha; o = (f32x4){0.f, 0.f, 0.f, 0.f}; hs[64 * q] = hbv; }
            u32x2 we, wo; we.x = pk2(e.x, e.y); we.y = pk2(e.z, e.w); wo.x = pk2(o.x, o.y); wo.y = pk2(o.z, o.w);
            oe[64 * q] = we; oo[64 * q] = wo; }
    }
}

__device__ __forceinline__ void ada_phase(LAS unsigned char* lds, const float* c, const float* c_ctx, const float* w_mod, const float* b_mod, float* ada, int G, int bid, int wv) {
    const int tid = wv * 64 + lane_id_v();
    LAS float* sc = (LAS float*)lds;
    LAS float* red = (LAS float*)(lds + 17 * 1024 * 4);
    for (int i = tid; i < 17 * 1024; i += 512) { const int s = i >> 10, k = i & 1023; const float v = (s < 16) ? c[s * 1024 + k] : c_ctx[k]; sc[i] = v / (1.0f + __expf(-v)); }
    __syncthreads();
    const int lane = tid & 63, w = tid >> 6, n4 = lane & 15, kr = lane >> 4;
    for (int item = bid; item < 288; item += G) {
        const int layer = item / 144, c0 = (item % 144) * 64;
        const float* W = w_mod + (size_t)layer * 1024 * NMOD + (size_t)(w * 128 + kr) * NMOD + c0 + 4 * n4;
        const LAS float* scp = sc + w * 128 + kr;
        f32x4 acc[17];
#pragma unroll
        for (int s = 0; s < 17; ++s) acc[s] = (f32x4){0.f, 0.f, 0.f, 0.f};
#pragma unroll 4
        for (int st = 0; st < 32; ++st) { const f32x4 wv = *(const f32x4*)(W + (size_t)(4 * st) * NMOD);
#pragma unroll
            for (int s = 0; s < 17; ++s) acc[s] += wv * scp[s * 1024 + 4 * st]; }
#pragma unroll
        for (int s = 0; s < 17; ++s)
#pragma unroll
            for (int e = 0; e < 4; ++e) { float v = acc[s][e]; v += __shfl_xor(v, 16); v += __shfl_xor(v, 32); if (lane < 16) red[(w * 17 + s) * 64 + 4 * n4 + e] = v; }
        __syncthreads();
        for (int o = tid; o < 17 * 64; o += 512) { const int s = o >> 6, cc = o & 63; float sum = 0.f;
#pragma unroll
            for (int q = 0; q < 8; ++q) sum += red[(q * 17 + s) * 64 + cc];
            ada[(size_t)(layer * 17 + s) * NMOD + c0 + cc] = sum + b_mod[layer * NMOD + c0 + cc]; }
        __syncthreads();
    }
}

__device__ __forceinline__ void qknorm_phase(bf16* Qr, bf16* Kr, const float* qg, const float* kg, const f32x2* rope, int vcu, int NGW, int wv) {
    const int tid = wv * 64 + lane_id_v(); asm volatile("" : "+s"(vcu), "+s"(NGW));
    const int lane = tid & 63, gw = vcu * 8 + __builtin_amdgcn_readfirstlane(tid >> 6);
    for (int it = gw; it < MC * 2; it += NGW) {
        const int r = it >> 1, which = it & 1, b = r / TOK, j = r % TOK;
        if (j < CTX && which == 0) continue;
        bf16* p = (which ? Kr : Qr) + (size_t)r * DM + lane * 16;
        const u32x4 w0 = *(const u32x4*)p, w1 = *(const u32x4*)(p + 8);
        float v[16];
        v[0] = bf_lo(w0.x); v[1] = bf_hi(w0.x); v[2] = bf_lo(w0.y); v[3] = bf_hi(w0.y); v[4] = bf_lo(w0.z); v[5] = bf_hi(w0.z); v[6] = bf_lo(w0.w); v[7] = bf_hi(w0.w);
        v[8] = bf_lo(w1.x); v[9] = bf_hi(w1.x); v[10] = bf_lo(w1.y); v[11] = bf_hi(w1.y); v[12] = bf_lo(w1.z); v[13] = bf_hi(w1.z); v[14] = bf_lo(w1.w); v[15] = bf_hi(w1.w);
        float ss = 0.f;
#pragma unroll
        for (int i = 0; i < 16; ++i) ss += v[i] * v[i];
        ss += shx<1>(ss); ss += shx<2>(ss);
        const float rstd = rsqrtf(ss * (1.f / 64.f) + EPS);
        const float* gn = (which ? kg : qg) + (lane & 3) * 16;
#pragma unroll
        for (int i = 0; i < 16; ++i) v[i] = v[i] * rstd * gn[i];
        if (j >= CTX) {
            const int pos = j - CTX, axis = (lane >> 1) & 1, half = lane & 1;
            const f32x2* cs = rope + ((size_t)pos * 2 + axis) * 16;
#pragma unroll
            for (int i = 0; i < 16; ++i) { const float pv = shx<1>(v[i]); const f32x2 t = cs[i];
                v[i] = half ? (v[i] * t.x + pv * t.y) : (v[i] * t.x - pv * t.y); }
        }
        if (which == 0) {
#pragma unroll
            for (int i = 0; i < 16; ++i) v[i] *= QSCALE;
        }
        u32x4 o0, o1;
        o0.x = pk2(v[0], v[1]); o0.y = pk2(v[2], v[3]); o0.z = pk2(v[4], v[5]); o0.w = pk2(v[6], v[7]);
        o1.x = pk2(v[8], v[9]); o1.y = pk2(v[10], v[11]); o1.z = pk2(v[12], v[13]); o1.w = pk2(v[14], v[15]);
        *(u32x4*)p = o0; *(u32x4*)(p + 8) = o1;
    }
}

constexpr int AT_ROW = 144, AT_SLOT = 128 * AT_ROW  , AT_K = 0, AT_V = 3 * AT_SLOT  , AT_X = 0, AT_OUT = 5 * AT_SLOT  , AT_OROW = 272;
__device__ __forceinline__ int crow(int i, int h) { return (i & 3) + 8 * (i >> 2) + 4 * h; }
#define MFMA32(a, b, c) __builtin_amdgcn_mfma_f32_32x32x16_bf16((a), (b), (c), 0, 0, 0)
__device__ __forceinline__ void attn_phase(LAS unsigned char* lds, const bf16* Q, const bf16* Kt, const bf16* VT, bf16* O, float out_scale, int G, int bid, int wv) {
    const int tid = wv * 64 + lane_id_v();
    const int lane = tid & 63, r = lane & 31, h = lane >> 5, wid = __builtin_amdgcn_readfirstlane(tid >> 6), c = wid & 1, qg = wid >> 1;
    asm volatile("" : "+s"(bid), "+s"(G));
    const int vcu = (G % 8 == 0) ? (bid % 8) * (G / 8) + bid / 8 : bid;
    const int srow = tid >> 3, spart = tid & 7;
    const int rsw = (r & 19) | ((r & 4) << 1) | ((r & 8) >> 1);
    const int koff = AT_K + (c * 64 + rsw) * AT_ROW + h * 16, voff = AT_V + r * AT_ROW + h * 16;
    const int sdst = srow * AT_ROW + spart * 16;
    constexpr int NT = TOK / 64;
    f32x16 zero16;
#pragma unroll
    for (int i = 0; i < 16; ++i) zero16[i] = 0.f;
    for (int unit = vcu; unit < NB * 8 * 16; unit += G) {
        const int bh = unit >> 4, qb = unit & 15, b = bh >> 3, hh = bh & 7, q0 = qb * 128;
        const bf16* qp = Q + ((size_t)b * TOK + CTX + q0 + qg * 32 + r) * DM + hh * 128 + c * 64 + h * 8;
        bf16x8 qf[4];
#pragma unroll
        for (int d0 = 0; d0 < 4; ++d0) qf[d0] = *(const bf16x8*)(qp + d0 * 16);
        const bf16* kg0 = Kt + ((size_t)b * TOK + srow) * DM + hh * 128 + spart * 8;
        const bf16* vg0 = VT + ((size_t)(b * 1024 + hh * 128 + srow)) * TOK + spart * 8;
        f32x16 o[4];
#pragma unroll
        for (int d = 0; d < 4; ++d)
#pragma unroll
            for (int i = 0; i < 16; ++i) o[d][i] = 0.f;
        float lsum0 = 0.f, lsum1 = 0.f;
        u32x4 stK[2], stV[2];
        {
            const u32x4 a0 = *(const u32x4*)(kg0), a1 = *(const u32x4*)(kg0 + 64), b0 = *(const u32x4*)(kg0 + (size_t)64 * DM), b1 = *(const u32x4*)(kg0 + (size_t)64 * DM + 64);
            const u32x4 v0 = *(const u32x4*)(vg0), v1 = *(const u32x4*)(vg0 + (size_t)64 * TOK);
            *(LAS u32x4*)(lds + AT_K + sdst) = a0; *(LAS u32x4*)(lds + AT_K + 64 * AT_ROW + sdst) = a1;
            *(LAS u32x4*)(lds + AT_K + AT_SLOT + sdst) = b0; *(LAS u32x4*)(lds + AT_K + AT_SLOT + 64 * AT_ROW + sdst) = b1;
            *(LAS u32x4*)(lds + AT_V + sdst) = v0; *(LAS u32x4*)(lds + AT_V + 64 * AT_ROW + sdst) = v1;
        }
        __syncthreads();
        f32x16 sc0, sc1, sn0, sn1;
        {
            sc0 = zero16; sc1 = zero16;
#pragma unroll
            for (int d0 = 0; d0 < 4; ++d0) { const bf16x8 k0 = *(const LAS bf16x8*)(lds + koff + d0 * 32), k1 = *(const LAS bf16x8*)(lds + koff + 32 * AT_ROW + d0 * 32);
                sc0 = MFMA32(k0, qf[d0], sc0); sc1 = MFMA32(k1, qf[d0], sc1); }
        }
        int ks_next = AT_SLOT, ks_fill = 2 * AT_SLOT;
#define ATT_BODY(HAS_NEXT) do { \
            const int vs = (t & 1) * AT_SLOT; \
            if (HAS_NEXT) { const int tk = (t + 2 < NT) ? t + 2 : NT - 1; const bf16* kg = kg0 + (size_t)tk * 64 * DM; const bf16* vg = vg0 + (t + 1) * 64; \
                stK[0] = *(const u32x4*)(kg); stK[1] = *(const u32x4*)(kg + 64); stV[0] = *(const u32x4*)(vg); stV[1] = *(const u32x4*)(vg + (size_t)64 * TOK); } \
            bf16x8 pf[2][2]; \
            {   \
                bf16x8 kf[2][4]; \
                if (HAS_NEXT) { _Pragma("unroll") for (int d0 = 0; d0 < 4; ++d0) { kf[0][d0] = *(const LAS bf16x8*)(lds + ks_next + koff + d0 * 32); kf[1][d0] = *(const LAS bf16x8*)(lds + ks_next + koff + 32 * AT_ROW + d0 * 32); } \
                    sn0 = MFMA32(kf[0][0], qf[0], zero16); sn1 = MFMA32(kf[1][0], qf[0], zero16); \
                    _Pragma("unroll") for (int d0 = 1; d0 < 4; ++d0) { sn0 = MFMA32(kf[0][d0], qf[d0], sn0); sn1 = MFMA32(kf[1][d0], qf[d0], sn1); } } \
                _Pragma("unroll") for (int i = 0; i < 16; i += 2) { sc0[i] = __builtin_amdgcn_exp2f(sc0[i]); sc0[i + 1] = __builtin_amdgcn_exp2f(sc0[i + 1]); lsum0 += sc0[i]; lsum1 += sc0[i + 1]; } \
                _Pragma("unroll") for (int sx = 0; sx < 2; ++sx) { u32x4 w; w.x = pk2(sc0[8 * sx], sc0[8 * sx + 1]); w.y = pk2(sc0[8 * sx + 2], sc0[8 * sx + 3]); w.z = pk2(sc0[8 * sx + 4], sc0[8 * sx + 5]); w.w = pk2(sc0[8 * sx + 6], sc0[8 * sx + 7]); pf[0][sx] = __builtin_bit_cast(bf16x8, w); } \
                if (HAS_NEXT) { __builtin_amdgcn_sched_group_barrier(0x100, 4, 0); _Pragma("unroll") for (int q = 0; q < 4; ++q) { __builtin_amdgcn_sched_group_barrier(0x8, 1, 0); __builtin_amdgcn_sched_group_barrier(0x100, 1, 0); __builtin_amdgcn_sched_group_barrier(0x402, 5, 0); } _Pragma("unroll") for (int q = 0; q < 4; ++q) { __builtin_amdgcn_sched_group_barrier(0x8, 1, 0); __builtin_amdgcn_sched_group_barrier(0x402, 5, 0); } } \
            } \
            __builtin_amdgcn_sched_barrier(0); \
            {   \
                bf16x8 vf[4][2]; \
                _Pragma("unroll") for (int sx = 0; sx < 2; ++sx) _Pragma("unroll") for (int dvb = 0; dvb < 4; ++dvb) vf[dvb][sx] = *(const LAS bf16x8*)(lds + vs + voff + dvb * 32 * AT_ROW + sx * 32); \
                _Pragma("unroll") for (int sx = 0; sx < 2; ++sx) _Pragma("unroll") for (int dvb = 0; dvb < 4; ++dvb) o[dvb] = MFMA32(vf[dvb][sx], pf[0][sx], o[dvb]); \
                _Pragma("unroll") for (int i = 0; i < 16; i += 2) { sc1[i] = __builtin_amdgcn_exp2f(sc1[i]); sc1[i + 1] = __builtin_amdgcn_exp2f(sc1[i + 1]); lsum0 += sc1[i]; lsum1 += sc1[i + 1]; } \
                _Pragma("unroll") for (int sx = 0; sx < 2; ++sx) { u32x4 w; w.x = pk2(sc1[8 * sx], sc1[8 * sx + 1]); w.y = pk2(sc1[8 * sx + 2], sc1[8 * sx + 3]); w.z = pk2(sc1[8 * sx + 4], sc1[8 * sx + 5]); w.w = pk2(sc1[8 * sx + 6], sc1[8 * sx + 7]); pf[1][sx] = __builtin_bit_cast(bf16x8, w); } \
                __builtin_amdgcn_sched_group_barrier(0x100, 4, 0); _Pragma("unroll") for (int q = 0; q < 4; ++q) { __builtin_amdgcn_sched_group_barrier(0x8, 1, 0); __builtin_amdgcn_sched_group_barrier(0x100, 1, 0); __builtin_amdgcn_sched_group_barrier(0x402, 5, 0); } _Pragma("unroll") for (int q = 0; q < 4; ++q) { __builtin_amdgcn_sched_group_barrier(0x8, 1, 0); __builtin_amdgcn_sched_group_barrier(0x402, 5, 0); } \
            } \
            __builtin_amdgcn_sched_barrier(0); \
            {   \
                bf16x8 vf[4][2]; \
                _Pragma("unroll") for (int sx = 0; sx < 2; ++sx) _Pragma("unroll") for (int dvb = 0; dvb < 4; ++dvb) vf[dvb][sx] = *(const LAS bf16x8*)(lds + vs + voff + dvb * 32 * AT_ROW + 64 + sx * 32); \
                _Pragma("unroll") for (int sx = 0; sx < 2; ++sx) _Pragma("unroll") for (int dvb = 0; dvb < 4; ++dvb) o[dvb] = MFMA32(vf[dvb][sx], pf[1][sx], o[dvb]); \
                __builtin_amdgcn_sched_group_barrier(0x100, 4, 0); _Pragma("unroll") for (int q = 0; q < 4; ++q) { __builtin_amdgcn_sched_group_barrier(0x8, 1, 0); __builtin_amdgcn_sched_group_barrier(0x100, 1, 0); } __builtin_amdgcn_sched_group_barrier(0x8, 4, 0); \
            } \
            if (HAS_NEXT) { *(LAS u32x4*)(lds + ks_fill + sdst) = stK[0]; *(LAS u32x4*)(lds + ks_fill + 64 * AT_ROW + sdst) = stK[1]; \
                *(LAS u32x4*)(lds + AT_V + (AT_SLOT - vs) + sdst) = stV[0]; *(LAS u32x4*)(lds + AT_V + (AT_SLOT - vs) + 64 * AT_ROW + sdst) = stV[1]; } \
            __syncthreads(); \
            if (HAS_NEXT) { sc0 = sn0; sc1 = sn1; const int tmp = ks_next; ks_next = ks_fill; ks_fill = (tmp == 0) ? 2 * AT_SLOT : tmp - AT_SLOT; } \
        } while (0)
        int t = 0;
        for (; t < NT - 1; ++t) ATT_BODY(true);
        ATT_BODY(false);
#undef ATT_BODY
        const float lsum = lsum0 + lsum1;
        KArgs ka = KA(); const float lam = P_SCAL[0]; const float* sub_g = ka->in[19];
        const float l = add_x32(lsum);
        LAS float* X = (LAS float*)(lds + AT_X);
        if (c == 1) { const float f = lam / l;
#pragma unroll
            for (int dvb = 0; dvb < 4; ++dvb)
#pragma unroll
                for (int i = 0; i < 16; ++i) X[(qg * 128 + dvb * 32 + crow(i, h)) * 32 + r] = o[dvb][i] * f; }
        __syncthreads();
        if (c == 0) { const float f = 1.0f / l; float ss = 0.f;
#pragma unroll
            for (int dvb = 0; dvb < 4; ++dvb)
#pragma unroll
                for (int i = 0; i < 16; ++i) { const float v = o[dvb][i] * f - X[(qg * 128 + dvb * 32 + crow(i, h)) * 32 + r]; o[dvb][i] = v; ss += v * v; }
            ss = add_x32(ss);
            const float rstd = rsqrtf(ss * (1.f / 128.f) + EPS) * out_scale;
#pragma unroll
            for (int dvb = 0; dvb < 4; ++dvb)
#pragma unroll
                for (int i4 = 0; i4 < 4; ++i4) { const int dv = dvb * 32 + 8 * i4 + 4 * h; const f32x4 sg = *(const f32x4*)(sub_g + dv);
                    u32x2 w; w.x = pk2(o[dvb][4 * i4] * rstd * sg.x, o[dvb][4 * i4 + 1] * rstd * sg.y); w.y = pk2(o[dvb][4 * i4 + 2] * rstd * sg.z, o[dvb][4 * i4 + 3] * rstd * sg.w);
                    *(LAS u32x2*)(lds + AT_OUT + (qg * 32 + r) * AT_OROW + dv * 2) = w; } }
        __syncthreads();
#pragma unroll
        for (int i = 0; i < 4; ++i) { const int ch = tid + 512 * i, row = ch >> 4, part = ch & 15;
            const u32x4 v = *(const LAS u32x4*)(lds + AT_OUT + row * AT_OROW + part * 16);
            *(u32x4*)(O + ((size_t)b * TOK + CTX + q0 + row) * DM + hh * 128 + part * 8) = v; }
    }
    __syncthreads();
}

__global__ void __launch_bounds__(512, 2) fwd_kernel(Args args) {
    extern __shared__ __attribute__((aligned(16))) unsigned char lds_raw[];
    LAS unsigned char* lds = (LAS unsigned char*)lds_raw;
    cg::grid_group grid = cg::this_grid();
    const int G = gridDim.x, bid = blockIdx.x;
    const int wv = __builtin_amdgcn_readfirstlane(threadIdx.x >> 6);
    const int vcu = (G % 8 == 0) ? (bid % 8) * (G / 8) + bid / 8 : bid;
    const int NGW = G * 8;
    const int lo = args.ph_lo, hi = args.ph_hi;
    int ph = 0;
    volatile LAS unsigned* bst = (volatile LAS unsigned*)(lds + LDS_BYTES - 64);
    { KArgs ka = KA(); unsigned* barw = (unsigned*)P_WS; const int tid = wv * 64 + lane_id_v();
      if (tid < 2) bst[tid] = 0u;
      if (bid == 0) { for (int i = tid; i < XCD_BAR_WORDS; i += 512) __hip_atomic_store(barw + i, 0u, __ATOMIC_RELAXED, __HIP_MEMORY_SCOPE_AGENT); }
      __syncthreads(); }
    unsigned xcc = 0;
#ifndef REP_MASK
#define REP_MASK 0
#endif
#define NREP(k) (((REP_MASK >> (k)) & 1) ? 2 : 1)
#define RUN() (lo <= ph && ph < hi)
#define XBAR() do { KArgs kb = KA(); XcdBarrier xb_; xb_.bar = (unsigned*)kb->ws; xb_.x = xcc; xb_.st = bst; xcd_barrier(xb_, wv == 0 && lane_id_v() == 0); } while (0)
#define SEAM() do { if (lo <= ph && ph + 1 < hi) { if (ph == 0) { grid.sync(); KArgs kb = KA(); xcc = xcd_barrier_post((unsigned*)kb->ws, bst, wv == 0 && lane_id_v() == 0).x; } else { XBAR(); if ((REP_MASK >> 6) & 1) { XBAR(); } } } ++ph; } while (0)

    if (RUN()) for (int rep = 0; rep < NREP(0); ++rep) {
        if (rep) grid.sync();
        KArgs ka = KA();
        for (int r2 = 0; r2 < NREP(8); ++r2) ada_phase(lds, ka->in[1], ka->in[3], ka->in[5], ka->in[6], P_ADA, G, bid, wv);
        const int tid = wv * 64 + lane_id_v();
        const int lane = tid & 63, wave = wv, gw = vcu * 8 + wave;
        LAS float* scr = (LAS float*)(lds + wave * 16640);
        constexpr int I_GU = 16 * 88, I_D = 44 * 16, I_QKV = 16 * 48, I_O = 16 * 16;
        constexpr int NITEMS = 4 * I_GU + 4 * I_D + I_QKV + 2 * I_O;
        for (int r2 = 0; r2 < NREP(9); ++r2)
        for (int it = gw; it < NITEMS; it += NGW) {
            int q = it;
            if (q < 4 * I_GU) { const int f = q / I_GU; transpose_item(((f & 1) ? ka->in[9] : ka->in[7]) + (size_t)(f >> 1) * DM * NGU, DM, NGU, (bf16*)(P_WS + WS_WGU + f * WGU_SZ), true, scr, q % I_GU, lane); continue; } q -= 4 * I_GU;
            if (q < 4 * I_D) { const int f = q / I_D; transpose_item(((f & 1) ? ka->in[10] : ka->in[8]) + (size_t)(f >> 1) * DFF * DM, DFF, DM, (bf16*)(P_WS + WS_WD + f * WD_SZ), false, scr, q % I_D, lane); continue; } q -= 4 * I_D;
            if (q < I_QKV) { transpose_item(ka->in[11], DM, 3072, P_WQKV, false, scr, q, lane); continue; } q -= I_QKV;
            if (q < I_O) { transpose_item(ka->in[12], DM, DM, P_WO, false, scr, q, lane); continue; } q -= I_O;
            transpose_item(ka->in[20], DM, DM, P_WF, false, scr, q, lane);
        }
        const int gt = vcu * 512 + tid, NGT = G * 512;
        for (int r2 = 0; r2 < NREP(10); ++r2)
        for (int i = gt; i < 2048 * 256; i += NGT) { const int k = i >> 8, j0 = (i & 255) * 8; const bool isS = j0 >= 1024; const int jj = j0 & 1023;
            float v[8];
#pragma unroll
            for (int e = 0; e < 8; ++e) { const int idx = (k * (jj + e)) & 2047; float sn, cs; sincospif((float)idx * (1.0f / 1024.0f), &sn, &cs); v[e] = (isS ? -sn : cs) * 0.02209708691f; }
            u32x4 w; w.x = pk2(v[0], v[1]); w.y = pk2(v[2], v[3]); w.z = pk2(v[4], v[5]); w.w = pk2(v[6], v[7]);
            *(u32x4*)(P_DFTS + (size_t)k * 2048 + j0) = w; }
        for (int i = gt; i < 512 * 32; i += NGT) { const int f = i >> 5, c0 = (i & 31) * 8; const bool isS = f >= 256; const int ff = f & 255;
            float v[8];
#pragma unroll
            for (int e = 0; e < 8; ++e) { const int idx = (ff * (c0 + e)) & 255; float sn, cs; sincospif((float)idx * (1.0f / 128.0f), &sn, &cs); v[e] = (isS ? sn : cs) * 0.0625f; }
            u32x4 w; w.x = pk2(v[0], v[1]); w.y = pk2(v[2], v[3]); w.z = pk2(v[4], v[5]); w.w = pk2(v[6], v[7]);
            *(u32x4*)(P_DFTC + (size_t)f * 256 + c0) = w; }
        for (int i = gt; i < 2048 * 32; i += NGT) { const int pos = i >> 5, axis = (i >> 4) & 1, p = i & 15;
            const float inv_freq = powf(10000.0f, -((float)p / 16.0f)); const float ang = (float)(axis ? (pos & 63) : (pos >> 6)) * inv_freq;
            float sn, cs; sincosf(ang, &sn, &cs); P_ROPE[i] = (f32x2){cs, sn}; }
        if (bid == 0 && wave == 0) {
            float p1 = wave_sum(ka->in[15][lane] * ka->in[16][lane]), p2 = wave_sum(ka->in[17][lane] * ka->in[18][lane]);
            float mq = fabsf(ka->in[13][lane]), mk = fabsf(ka->in[14][lane]);
#pragma unroll
            for (int o = 1; o < 64; o <<= 1) { mq = fmaxf(mq, __shfl_xor(mq, o)); mk = fmaxf(mk, __shfl_xor(mk, o)); }
            if (lane == 0) { P_SCAL[0] = expf(p1) - expf(p2) + 0.2f; P_SCAL[1] = 8.0f * mq * mk * 1.44269504089f; }
        }
    }
    SEAM();

    for (int fi = 0; fi < 4; ++fi) {
#define FI() int fi_ = fi; asm volatile("" : "+s"(fi_)); const int layer = fi_ >> 1, which = fi_ & 1; const bool with_ctx = (fi_ == 0); (void)layer; (void)which; (void)with_ctx
        if (RUN()) for (int rep = 0; rep < NREP(1); ++rep) { KArgs ka = KA(); FI();
            norm_phase((fi_ == 0) ? ka->in[0] : (const float*)P_OUT, ka->in[2], ka->in[4] + (size_t)(layer * 3 + which * 2) * DM, P_ADA + (size_t)layer * 17 * NMOD, which * 6, P_HB, with_ctx, vcu, NGW, wv); }
        SEAM();
        if (RUN()) for (int rep = 0; rep < NREP(2); ++rep) {
            if (rep) XBAR();
            KArgs ka = KA(); FI();
            pg8::Gemm g{P_HB, (const bf16*)(P_WS + WS_WGU + fi_ * WGU_SZ), DM, DM, DM, 0u, 0u};
            pg8::Order S; S.init(with_ctx ? 144 : 128, 22, 1, with_ctx ? 0 : 1, 0, G, bid);
            pg8::EpiSwiglu E{P_BIG};
            pg8::gemm_phase<pg8::EpiSwiglu, pg8::Order>(lds, g, S, E, wv);
        }
        SEAM();
        if (RUN()) { KArgs ka = KA(); FI();
            pg8::Gemm g{P_BIG, (const bf16*)(P_WS + WS_WD + fi_ * WD_SZ), DFF, DFF, DFF, 0u, 0u};
            pg8::Order S; S.init(with_ctx ? 144 : 128, 4, 1, with_ctx ? 0 : 1, 0, G, bid);
            pg8::EpiGateRes E{fi_ == 0 ? 1 : 0, layer, which * 6 + 2, 0.5f};
            pg8::gemm_phase<pg8::EpiGateRes, pg8::Order>(lds, g, S, E, wv);
        }
        SEAM();
        if ((fi & 1) == 0) {
            if (RUN()) for (int rep = 0; rep < NREP(7); ++rep) { KArgs ka = KA(); FI();
                if (layer == 0) norm_phase(P_OUT, P_Y1, ka->in[4] + (size_t)(layer * 3 + 1) * DM, P_ADA + (size_t)layer * 17 * NMOD, 3, P_HB, true, vcu, NGW, wv);
                else norm_fourier_phase(P_OUT, ka->in[4] + (size_t)(layer * 3 + 1) * DM, P_ADA + (size_t)layer * 17 * NMOD, P_HB, (float*)(P_WS + WS_H1024), vcu, NGW, wv); }
            SEAM();
            if (fi == 0) {
                if (RUN()) for (int rep = 0; rep < NREP(5); ++rep) {
                    if (rep) XBAR();
                    { KArgs ka = KA();
                        pg8::Gemm g{P_HB, P_WQKV, DM, DM, DM, 0u, 0u}; pg8::Order S; S.init(144, 8, 1, 0, 0, G, bid); pg8::EpiBf16Split E{P_BIG, DM, DM, QK_STRIDE};
                        pg8::gemm_phase<pg8::EpiBf16Split, pg8::Order>(lds, g, S, E, wv); }
                    { KArgs ka = KA();
                        pg8::Gemm g{P_WQKV + (size_t)2048 * DM, P_HB, DM, DM, DM, 0u, 0u}; pg8::Order S; S.init(4, 144, 1, 0, 0, G, bid); pg8::EpiBf16Split E{P_BIG + 2 * QK_STRIDE, TOK, TOK, (size_t)1024 * TOK};
                        pg8::gemm_phase<pg8::EpiBf16Split, pg8::Order>(lds, g, S, E, wv); }
                }
                SEAM();
                if (RUN()) { KArgs ka = KA(); qknorm_phase(P_BIG, P_BIG + QK_STRIDE, ka->in[13], ka->in[14], P_ROPE, vcu, NGW, wv); }
                SEAM();
                if (RUN()) for (int rep = 0; rep < NREP(3); ++rep) { KArgs ka = KA();
                    attn_phase(lds, P_BIG, P_BIG + QK_STRIDE, P_BIG + 2 * QK_STRIDE, P_HB, 0.8f, G, bid, wv); }
                SEAM();
            } else {
                if (RUN()) for (int rep = 0; rep < NREP(4); ++rep) {
                    if (rep) XBAR();
                    KArgs ka = KA();
                    pg8::Gemm g{P_DFTC, P_HB, 256, 256, DM, 0u, 512u};
                    pg8::Order S; S.init(1, 128, 4, 0, 1, G, bid); S.chan = 1;
                    pg8::EpiChan E{P_BIG};
                    pg8::gemm_phase<pg8::EpiChan, pg8::Order>(lds, g, S, E, wv);
                    {   KArgs ka = KA();
                        const int tid = wv * 64 + lane_id_v();
                        const int i = vcu * 512 + tid;
                        if (i < NB * 1024) { const int b = i >> 10, chn = i & 1023, gq = chn >> 8, m = chn & 255;
                            const f32x4* hp = (const f32x4*)((const float*)(P_WS + WS_H1024) + (size_t)b * DM + gq * 256); const u32x2* cp = (const u32x2*)(P_DFTC + (size_t)m * 256);
                            float sum = 0.f;
#pragma unroll 4
                            for (int c4 = 0; c4 < 64; ++c4) { const f32x4 hv = hp[c4]; const u32x2 cw = cp[c4];
                                sum += hv.x * bf_lo(cw.x) + hv.y * bf_hi(cw.x) + hv.z * bf_lo(cw.y) + hv.w * bf_hi(cw.y); }
                            ((float*)(P_WS + WS_T))[i] = sum * 0.02209708691f; }
                    }
                }
                SEAM();
                if (RUN()) for (int rep = 0; rep < NREP(4); ++rep) {
                    if (rep) XBAR();
                    KArgs ka = KA();
                    pg8::Gemm g{P_DFTS, P_BIG, 2048, 2048, 2048, 0u, 0u};
                    pg8::Order S; S.init(8, 64, 1, 0, 0, G, bid);
                    pg8::EpiSeq E{P_HB + (size_t)CTX * DM, (const float*)(P_WS + WS_T)};
                    pg8::gemm_phase<pg8::EpiSeq, pg8::Order>(lds, g, S, E, wv);
                }
                SEAM();
            }
            if (RUN()) { KArgs ka = KA(); FI();
                pg8::Gemm g{P_HB, layer == 0 ? P_WO : P_WF, DM, DM, DM, 0u, 0u};
                pg8::Order S; S.init(128, 4, 1, 1, 0, G, bid);
                pg8::EpiGateRes E{0, layer, 5, 1.0f};
                pg8::gemm_phase<pg8::EpiGateRes, pg8::Order>(lds, g, S, E, wv);
            }
            SEAM();
        }
    }
#undef RUN
#undef SEAM
}

extern "C" void kernel_launch(void* const* d_in, const int* in_sizes, int n_in, void* d_out, int out_size, void* d_ws, size_t ws_size, hipStream_t stream) {
    static int grid = 0;
    if (grid == 0) {
        if (n_in != 21 || ws_size < WS_END) { fprintf(stderr, "kernel_launch: unexpected n_in %d / ws %zu\n", n_in, ws_size); grid = -1; return; }
        int dev = 0, cus = 0, per_cu = 0;
        hipGetDevice(&dev); hipDeviceGetAttribute(&cus, hipDeviceAttributeMultiprocessorCount, dev);
        if (hipFuncSetAttribute((const void*)fwd_kernel, hipFuncAttributeMaxDynamicSharedMemorySize, LDS_BYTES) != hipSuccess) { fprintf(stderr, "kernel_launch: hipFuncSetAttribute failed\n"); grid = -1; return; }
        if (hipOccupancyMaxActiveBlocksPerMultiprocessor(&per_cu, (const void*)fwd_kernel, 512, LDS_BYTES) != hipSuccess || per_cu < 1) { fprintf(stderr, "kernel_launch: occupancy query gave %d\n", per_cu); per_cu = 1; }
        (void)hipGetLastError();
        grid = cus * per_cu;
    }
    if (grid < 0) return;
    Args a{};
    for (int i = 0; i < 21; ++i) a.in[i] = (const float*)d_in[i];
    a.out = (float*)d_out; a.ws = (unsigned char*)d_ws; a.ph_lo = 0; a.ph_hi = 1000;
    void* kargs[] = {&a};
    hipError_t e = hipLaunchCooperativeKernel((const void*)fwd_kernel, dim3(grid), dim3(512), kargs, LDS_BYTES, stream);
    if (e != hipSuccess) fprintf(stderr, "cooperative launch failed: %s (grid %d)\n", hipGetErrorString(e), grid);
}
```

```cpp
#include <hip/hip_runtime.h>
#include <hip/hip_cooperative_groups.h>
#include <cstdio>
#include <cstdint>
namespace cg = cooperative_groups;

#define LAS __attribute__((address_space(3)))
typedef unsigned short bf16;
typedef short bf16x8 __attribute__((ext_vector_type(8)));
typedef float f32x4 __attribute__((ext_vector_type(4)));
typedef float f32x2 __attribute__((ext_vector_type(2)));
typedef float f32x16 __attribute__((ext_vector_type(16)));
typedef unsigned u32x4 __attribute__((ext_vector_type(4)));
typedef unsigned u32x2 __attribute__((ext_vector_type(2)));
typedef __bf16 bf16x2_t __attribute__((ext_vector_type(2)));

__device__ __forceinline__ unsigned pk2(float lo, float hi) { f32x2 v = {lo, hi}; bf16x2_t b = __builtin_convertvector(v, bf16x2_t); return __builtin_bit_cast(unsigned, b); }
__device__ __forceinline__ float bf_lo(unsigned w) { return __uint_as_float(w << 16); }
__device__ __forceinline__ float bf_hi(unsigned w) { return __uint_as_float(w & 0xffff0000u); }
__device__ __forceinline__ int lane_id_v() { int l; asm volatile("v_mbcnt_lo_u32_b32 %0, -1, 0\n\tv_mbcnt_hi_u32_b32 %0, -1, %0" : "=v"(l)); return l; }
template <int M> __device__ __forceinline__ float shx(float v) { return __builtin_bit_cast(float, __builtin_amdgcn_ds_swizzle(__builtin_bit_cast(int, v), (M << 10) | 0x1f)); }
__device__ __forceinline__ float add_x32(float v) { const unsigned u = __builtin_bit_cast(unsigned, v); auto rr = __builtin_amdgcn_permlane32_swap(u, u, false, false); return __uint_as_float(rr[0]) + __uint_as_float(rr[1]); }
__device__ __forceinline__ float wave_sum(float v) { v += shx<1>(v); v += shx<2>(v); v += shx<4>(v); v += shx<8>(v); v += shx<16>(v); return add_x32(v); }

constexpr int DM = 1024, NB = 16, SEQ = 2048, CTX = 256, TOK = 2304, MC = NB * TOK  , MX = NB * SEQ  , DFF = 2816, NGU = 5632, NMOD = 9216;
constexpr float EPS = 1e-6f;
constexpr float QSCALE = 0.125f * 1.44269504089f;
constexpr size_t MiB = 1u << 20;
constexpr size_t WS_ADA = 1 * MiB;
constexpr size_t WS_SCAL = 3 * MiB;
constexpr size_t WS_ROPE = 3 * MiB + 4096;
constexpr size_t WS_H1024 = 3 * MiB + 640 * 1024;
constexpr size_t WS_T = 3 * MiB + 768 * 1024;
constexpr size_t WS_WGU = 4 * MiB;
constexpr size_t WS_WD = 48 * MiB;
constexpr size_t WS_WQKV = 70 * MiB;
constexpr size_t WS_WO = 76 * MiB;
constexpr size_t WS_WF = 78 * MiB;
constexpr size_t WS_DFTS = 80 * MiB;
constexpr size_t WS_DFTC = 96 * MiB;
constexpr size_t WS_Y1 = 98 * MiB;
constexpr size_t WS_HB = 114 * MiB;
constexpr size_t WS_BIG = 186 * MiB;
constexpr size_t WS_Y1B = 402 * MiB;
constexpr size_t WS_END = 418 * MiB;
constexpr size_t WGU_SZ = (size_t)NGU * DM * 2, WD_SZ = (size_t)DM * DFF * 2;
constexpr size_t QK_STRIDE = (size_t)MC * DM;
constexpr int LDS_BYTES = 147456;

struct Args { const float* in[21]; float* out; unsigned char* ws; int ph_lo, ph_hi; };
typedef const __attribute__((address_space(4))) Args* KArgs;
#define KA() ({ KArgs _p = (KArgs)__builtin_amdgcn_kernarg_segment_ptr(); asm volatile("" : "+s"(_p)); _p; })
#define P_WS   (ka->ws)
#define P_OUT  (ka->out)
#define P_ADA  ((float*)(ka->ws + WS_ADA))
#define P_SCAL ((float*)(ka->ws + WS_SCAL))
#define P_ROPE ((f32x2*)(ka->ws + WS_ROPE))
#define P_WQKV ((bf16*)(ka->ws + WS_WQKV))
#define P_WO   ((bf16*)(ka->ws + WS_WO))
#define P_WF   ((bf16*)(ka->ws + WS_WF))
#define P_DFTS ((bf16*)(ka->ws + WS_DFTS))
#define P_DFTC ((bf16*)(ka->ws + WS_DFTC))
#define P_Y1   ((float*)(ka->ws + WS_Y1))
#define P_Y1B  ((float*)(ka->ws + WS_Y1B))
#define P_HB   ((bf16*)(ka->ws + WS_HB))
#define P_BIG  ((bf16*)(ka->ws + WS_BIG))

namespace pg8 {
#define PG8_LAS __attribute__((address_space(3)))
typedef unsigned short bf16_t;
constexpr int BM = 256, BK = 64, HALF = 128, HTB = HALF * BK * 2, STAGE_BYTES = 8 * HTB, NXCD = 8, WGM = 8;

__host__ __device__ __forceinline__ int lds_byte(int r, int c) { const int st = (r >> 4) * 2 + (c >> 5), rr = r & 15, cc = c & 31, ob = rr * 64 + cc * 2; return st * 1024 + (ob ^ (((ob >> 9) & 1) << 5)); }
__host__ __device__ __forceinline__ void stage_rc(int b, int& R, int& C) { const int st = b / 1024, sb = b % 1024, swz = sb ^ (((sb >> 9) & 1) << 5); R = (st >> 1) * 16 + swz / 64; C = (st & 1) * 32 + (swz % 64) / 2; }
__host__ __device__ __forceinline__ int perm32(int rho) { const int n = rho >> 4, i = rho & 15; return 8 * (i >> 2) + 4 * n + (i & 3); }

struct Unit { int pm, pn, g, kt0, ktn; };
struct Gemm { const bf16_t* A; const bf16_t* Bt; int K, lda, ldb; long long gstepA, gstepB; };

struct Order {
    int nM, nN, per, total, G, c, remapM, remapN, chan, swapg, ctxsplit;
    __device__ __forceinline__ void init(int nM_, int nN_, int nG_, int remapM_, int remapN_, int G_, int c_) { asm volatile("" : "+s"(c_), "+s"(G_));
        nM = nM_; nN = nN_; per = nM_ * nN_; total = per * nG_; remapM = remapM_; remapN = remapN_; G = G_; c = c_; chan = 0; swapg = 0; ctxsplit = 0; }
    __device__ __forceinline__ bool next(int i, Unit& u) const {
        const long L = (long)i * G + c; if (L >= total + ctxsplit) return false;
        u.kt0 = 0; u.ktn = 0;
        if (L >= total) {
            const int idx = (int)L - total, t = idx >> 1; u.g = idx & 1; u.pm = (t >> 2) * 9; u.pn = t & 3; u.kt0 = u.g * 22; u.ktn = 22; return true; }
        int wgid = (int)L; { const int q = total / NXCD, r = total % NXCD, xcd = wgid % NXCD, off = wgid / NXCD; wgid = (xcd < r ? xcd * (q + 1) : r * (q + 1) + (xcd - r) * q) + off; }
        u.g = wgid / per; const int w = wgid % per;
        const bool sw = swapg && u.g; const int nM = sw ? this->nN : this->nM, nN = sw ? this->nM : this->nN;
        const int nig = WGM * nN, gid = w / nig, fm = gid * WGM, gsz = (nM - fm) < WGM ? (nM - fm) : WGM;
        int pm = fm + ((w % nig) % gsz), pn = (w % nig) / gsz;
        if (remapM) pm = (pm >> 3) * 9 + 1 + (pm & 7);
        if (remapN) pn = (pn >> 3) * 9 + 1 + (pn & 7);
        if (chan) pm = ((pn % 9) - 1) >> 2;
        u.pm = pm; u.pn = pn; return true;
    }
    __device__ __forceinline__ void a_ready(const Unit&) const {}
    __device__ __forceinline__ void done(const Unit&) const {}
};

struct EpiBf16Split {
    static constexpr bool PERM = true, AFTER_DRAIN = false;
    bf16_t* O; int ldc; int split_cols; size_t split_stride;
    __device__ __forceinline__ void operator()(const f32x4 (&acc)[2][2][4][2], const Unit& u, int wr, int wc, int fr, int fq) const {
        const int row0 = u.pm * BM + wr * 64 + fr; int colt = u.pn * BM; bf16_t* base = O;
        { const int t = colt / split_cols; base += (size_t)t * split_stride; colt -= t * split_cols; }
        const int col0 = colt + wc * 32 + 8 * fq;
#pragma unroll
        for (int ai = 0; ai < 2; ++ai)
#pragma unroll
            for (int m = 0; m < 4; ++m) { bf16_t* rowp = base + (size_t)(row0 + ai * HALF + m * 16) * ldc + col0;
#pragma unroll
                for (int bj = 0; bj < 2; ++bj) { const f32x4 v0 = acc[ai][bj][m][0], v1 = acc[ai][bj][m][1];
                    u32x4 w; w.x = pk2(v0[0], v0[1]); w.y = pk2(v0[2], v0[3]); w.z = pk2(v1[0], v1[1]); w.w = pk2(v1[2], v1[3]);
                    *(u32x4*)(rowp + bj * HALF) = w; } }
    }
};
struct EpiQKV {
    static constexpr bool PERM = true, AFTER_DRAIN = false;
    int call;
    __device__ __forceinline__ void operator()(const f32x4 (&acc)[2][2][4][2], const Unit& u, int wr, int wc, int fr, int fq) const {
        asm volatile("" : "+v"(fr), "+v"(fq));
        KArgs ka = KA();
        if (call == 2 && u.g == 1) {
            const int row0 = u.pm * BM + wr * 64 + fr; int colt = u.pn * BM; const int t = colt / TOK; colt -= t * TOK;
            bf16_t* base = P_BIG + 2 * QK_STRIDE + (size_t)t * 1024 * TOK; const int col0 = colt + wc * 32 + 8 * fq;
#pragma unroll
            for (int ai = 0; ai < 2; ++ai)
#pragma unroll
                for (int m = 0; m < 4; ++m) { bf16_t* rowp = base + (size_t)(row0 + ai * HALF + m * 16) * TOK + col0;
#pragma unroll
                    for (int bj = 0; bj < 2; ++bj) { const f32x4 v0 = acc[ai][bj][m][0], v1 = acc[ai][bj][m][1];
                        u32x4 w; w.x = pk2(v0[0], v0[1]); w.y = pk2(v0[2], v0[3]); w.z = pk2(v1[0], v1[1]); w.w = pk2(v1[2], v1[3]);
                        *(u32x4*)(rowp + bj * HALF) = w; } }
            return;
        }
        const bool isK = (call == 2);
        const int jt = u.pm % 9;
        bf16_t* base = P_BIG + (isK ? QK_STRIDE : 0) + (size_t)(u.pm * BM) * DM + (u.pn * 4 + wc) * 64;
        const float* gn = isK ? ka->in[14] : ka->in[13];
        float cf[2][4];
#pragma unroll
        for (int n = 0; n < 2; ++n)
#pragma unroll
            for (int e = 0; e < 4; ++e) cf[n][e] = __builtin_amdgcn_exp2f(-(float)(8 * (fq & 1) + 4 * n + e) * 0.830482023722f) * 0.159154943092f;
        f32x4 gv[2][2];
#pragma unroll
        for (int bj = 0; bj < 2; ++bj)
#pragma unroll
            for (int n = 0; n < 2; ++n) gv[bj][n] = *(const f32x4*)(gn + bj * 32 + 8 * fq + 4 * n);
        const bool hi = fq >= 2;
#pragma unroll
        for (int ai = 0; ai < 2; ++ai)
#pragma unroll
            for (int m = 0; m < 4; ++m) {
                const int rl = ai * HALF + wr * 64 + m * 16 + fr;
                float ss = 0.f;
#pragma unroll
                for (int bj = 0; bj < 2; ++bj)
#pragma unroll
                    for (int n = 0; n < 2; ++n) { const f32x4 a = acc[ai][bj][m][n]; ss += (a.x * a.x + a.y * a.y) + (a.z * a.z + a.w * a.w); }
                ss += shx<16>(ss); ss = add_x32(ss);
                const float rstd = rsqrtf(ss * (1.f / 64.f) + EPS);
                f32x4 v[2][2];
#pragma unroll
                for (int bj = 0; bj < 2; ++bj)
#pragma unroll
                    for (int n = 0; n < 2; ++n) v[bj][n] = acc[ai][bj][m][n] * rstd * gv[bj][n];
                if (jt > 0) {
                    const int pos = (jt - 1) * 256 + rl;
#pragma unroll
                    for (int bj = 0; bj < 2; ++bj) { const float apos = (float)(bj ? (pos & 63) : (pos >> 6));
#pragma unroll
                        for (int n = 0; n < 2; ++n) {
                            f32x4 pv, cs, sn;
#pragma unroll
                            for (int e = 0; e < 4; ++e) { const float xr = __builtin_amdgcn_fractf(apos * cf[n][e]); sn[e] = __builtin_amdgcn_sinf(xr); cs[e] = __builtin_amdgcn_cosf(xr); }
#pragma unroll
                            for (int e = 0; e < 4; ++e) { float pa = v[bj][n][e], pb = pa;
                                asm volatile("s_nop 1\n\tv_permlane32_swap_b32 %0, %1" : "+v"(pa), "+v"(pb)); pv[e] = hi ? pa : pb; }
                            v[bj][n] = hi ? (v[bj][n] * cs + pv * sn) : (v[bj][n] * cs - pv * sn); } }
                }
                if (!isK) {
#pragma unroll
                    for (int bj = 0; bj < 2; ++bj)
#pragma unroll
                        for (int n = 0; n < 2; ++n) v[bj][n] = v[bj][n] * QSCALE;
                }
                bf16_t* rowp = base + (size_t)rl * DM + 8 * fq;
#pragma unroll
                for (int bj = 0; bj < 2; ++bj) { u32x4 w; w.x = pk2(v[bj][0][0], v[bj][0][1]); w.y = pk2(v[bj][0][2], v[bj][0][3]); w.z = pk2(v[bj][1][0], v[bj][1][1]); w.w = pk2(v[bj][1][2], v[bj][1][3]);
                    *(u32x4*)(rowp + bj * 32) = w; }
            }
    }
};
struct EpiSwiglu {
    static constexpr bool PERM = true, AFTER_DRAIN = false;
    bf16_t* O;
    __device__ __forceinline__ void operator()(const f32x4 (&acc)[2][2][4][2], const Unit& u, int wr, int wc, int fr, int fq) const {
        const int row0 = u.pm * BM + wr * 64 + fr, col0 = u.pn * HALF + wc * 32 + 8 * fq;
#pragma unroll
        for (int ai = 0; ai < 2; ++ai)
#pragma unroll
            for (int m = 0; m < 4; ++m) { bf16_t* rowp = O + (size_t)(row0 + ai * HALF + m * 16) * 2816 + col0;
                float v[8];
#pragma unroll
                for (int n = 0; n < 2; ++n)
#pragma unroll
                    for (int j = 0; j < 4; ++j) { const float g = acc[ai][0][m][n][j], uu = acc[ai][1][m][n][j];
                        v[4 * n + j] = g * uu * __builtin_amdgcn_rcpf(1.0f + __builtin_amdgcn_exp2f(-g)); }
                u32x4 w; w.x = pk2(v[0], v[1]); w.y = pk2(v[2], v[3]); w.z = pk2(v[4], v[5]); w.w = pk2(v[6], v[7]);
                *(u32x4*)rowp = w; }
    }
};
struct EpiGateRes {
    static constexpr bool PERM = false, AFTER_DRAIN = false;
    int first; int layer; int kg; float coef;
    __device__ __forceinline__ void operator()(const f32x4 (&acc)[2][2][4][2], const Unit& u, int wr, int wc, int fr, int fq) const {
        KArgs ka = KA();
        const int b = u.pm / 9, j = u.pm % 9; const float* rb; float* ob; int s;
        const bool nores = u.ktn && u.g;
        if (j == 0) { const size_t off = (size_t)b * 256 * 1024; rb = ka->in[2] + off; ob = (nores ? P_Y1B : P_Y1) + off; s = 16; }
        else { const size_t off = ((size_t)b * 2048 + (size_t)(j - 1) * 256) * 1024; rb = (first ? ka->in[0] : (const float*)P_OUT) + off; ob = P_OUT + off; s = b; }
        const float* gate = P_ADA + (size_t)layer * 17 * NMOD + (size_t)(s * 9 + kg) * 1024;
        const int row0 = wr * 64 + fr, col0 = u.pn * BM + wc * 32 + 4 * fq;
        f32x4 gv[2][2];
#pragma unroll
        for (int bj = 0; bj < 2; ++bj)
#pragma unroll
            for (int n = 0; n < 2; ++n) gv[bj][n] = *(const f32x4*)(gate + col0 + bj * HALF + n * 16) * coef;
        constexpr int NB_ = 4;
#pragma unroll
        for (int ai = 0; ai < 2; ++ai)
#pragma unroll
            for (int m0 = 0; m0 < 4; m0 += NB_) {
                f32x4 r[NB_][2][2];
#pragma unroll
                for (int mm = 0; mm < NB_; ++mm) { const size_t roff = (size_t)(row0 + ai * HALF + (m0 + mm) * 16) * 1024 + col0;
#pragma unroll
                    for (int bj = 0; bj < 2; ++bj)
#pragma unroll
                        for (int n = 0; n < 2; ++n) { r[mm][bj][n] = (f32x4){0.f, 0.f, 0.f, 0.f}; if (!nores) r[mm][bj][n] = *(const f32x4*)(rb + roff + bj * HALF + n * 16); } }
#pragma unroll
                for (int mm = 0; mm < NB_; ++mm) { const size_t roff = (size_t)(row0 + ai * HALF + (m0 + mm) * 16) * 1024 + col0;
#pragma unroll
                    for (int bj = 0; bj < 2; ++bj)
#pragma unroll
                        for (int n = 0; n < 2; ++n) *(f32x4*)(ob + roff + bj * HALF + n * 16) = r[mm][bj][n] + gv[bj][n] * acc[ai][bj][m0 + mm][n]; } }
    }
};
struct EpiChan {
    static constexpr bool PERM = true, AFTER_DRAIN = false;
    bf16_t* XT;
    __device__ __forceinline__ void operator()(const f32x4 (&acc)[2][2][4][2], const Unit& u, int wr, int wc, int fr, int fq) const {
        const int b = u.pn / 9, jt = u.pn % 9 - 1;
        bf16_t* base = XT + (size_t)(b * 1024 + u.g * 256) * 2048 + jt * 256;
        const int row0 = wr * 64 + fr, col0 = wc * 32 + 8 * fq;
#pragma unroll
        for (int ai = 0; ai < 2; ++ai)
#pragma unroll
            for (int m = 0; m < 4; ++m) { bf16_t* rowp = base + (size_t)(row0 + ai * HALF + m * 16) * 2048 + col0;
#pragma unroll
                for (int bj = 0; bj < 2; ++bj) { const f32x4 v0 = acc[ai][bj][m][0], v1 = acc[ai][bj][m][1];
                    u32x4 w; w.x = pk2(v0[0], v0[1]); w.y = pk2(v0[2], v0[3]); w.z = pk2(v1[0], v1[1]); w.w = pk2(v1[2], v1[3]);
                    *(u32x4*)(rowp + bj * HALF) = w; } }
    }
};
struct EpiSeq {
    static constexpr bool PERM = true, AFTER_DRAIN = false;
    bf16_t* O; const float* T;
    __device__ __forceinline__ void operator()(const f32x4 (&acc)[2][2][4][2], const Unit& u, int wr, int wc, int fr, int fq) const {
        const int row0 = u.pm * BM + wr * 64 + fr; const int colt = u.pn * BM; const int b = colt >> 10;
        bf16_t* base = O + (size_t)b * 2304 * 1024;
        const int col0 = (colt & 1023) + wc * 32 + 8 * fq;
        const float sg = (fr & 1) ? -1.0f : 1.0f;
        f32x4 tv[2][2];
#pragma unroll
        for (int bj = 0; bj < 2; ++bj)
#pragma unroll
            for (int n = 0; n < 2; ++n) tv[bj][n] = *(const f32x4*)(T + colt + wc * 32 + 8 * fq + bj * HALF + 4 * n) * sg;
#pragma unroll
        for (int ai = 0; ai < 2; ++ai)
#pragma unroll
            for (int m = 0; m < 4; ++m) { bf16_t* rowp = base + (size_t)(row0 + ai * HALF + m * 16) * 1024 + col0;
#pragma unroll
                for (int bj = 0; bj < 2; ++bj) { const f32x4 v0 = acc[ai][bj][m][0] + tv[bj][0], v1 = acc[ai][bj][m][1] + tv[bj][1];
                    u32x4 w; w.x = pk2(v0[0], v0[1]); w.y = pk2(v0[2], v0[3]); w.z = pk2(v1[0], v1[1]); w.w = pk2(v1[2], v1[3]);
                    *(u32x4*)(rowp + bj * HALF) = w; } }
    }
};

template <class Epi, class Sched, bool ALIGN_EPI = true>
__device__ __forceinline__ void gemm_phase(PG8_LAS unsigned char* lds, const Gemm g, const Sched& S, const Epi& E, int wv) {
    const int tid = wv * 64 + lane_id_v();
    const int wid = __builtin_amdgcn_readfirstlane(tid >> 6), lane = tid & 63, wr = wid >> 2, wc = wid & 3, fr = lane & 15, fq = lane >> 4;
    int K = g.K, lda = g.lda, ldb = g.ldb; asm volatile("" : "+s"(K), "+s"(lda), "+s"(ldb));
    const int ntK = K / BK;
    unsigned voffA[2], voffB[2];
#pragma unroll
    for (int i = 0; i < 2; ++i) { int R, C; stage_rc(tid * 16 + i * 8192, R, C); const int Rb = Epi::PERM ? ((R & ~31) + perm32(R & 31)) : R;
        voffA[i] = (unsigned)(R * lda + C) * 2u; voffB[i] = (unsigned)(Rb * ldb + C) * 2u; }
    const size_t kstep = (size_t)(BK * 2);
    const size_t hstepA = (size_t)HALF * lda * 2, hstepB = (size_t)HALF * ldb * 2;
    const size_t tstepA = 2 * hstepA, tstepB = 2 * hstepB;
    const unsigned ldsw = (unsigned)wid * 1024u;
    const int aoff = lds_byte(wr * 64 + fr, fq * 8), boff = lds_byte(wc * 32 + fr, fq * 8);
#define PG8_SA(b, h) (((b) * 2 + (h)) * HTB)
#define PG8_SB(b, h) ((4 + (b) * 2 + (h)) * HTB)
#define PG8_STAGE(bufoff, gbase, voff) do { _Pragma("unroll") for (int _i = 0; _i < 2; ++_i) \
        __builtin_amdgcn_global_load_lds((const unsigned*)((const char*)(gbase) + (voff)[_i]), (PG8_LAS unsigned*)(lds + (bufoff) + ldsw + _i * 8192), 16, 0, 0); } while (0)
#define PG8_LDA(dst, b, h) do { _Pragma("unroll") for (int m = 0; m < 4; ++m) _Pragma("unroll") for (int k = 0; k < 2; ++k) dst[m][k] = *(const PG8_LAS bf16x8*)(lds + PG8_SA(b, h) + aoff + m * 2048 + k * 1024); } while (0)
#define PG8_LDB(dst, b, h) do { _Pragma("unroll") for (int n = 0; n < 2; ++n) _Pragma("unroll") for (int k = 0; k < 2; ++k) dst[n][k] = *(const PG8_LAS bf16x8*)(lds + PG8_SB(b, h) + boff + n * 2048 + k * 1024); } while (0)
#define PG8_MMA(ai, bj, At, Bt) do { __builtin_amdgcn_s_setprio(1); _Pragma("unroll") for (int m = 0; m < 4; ++m) _Pragma("unroll") for (int n = 0; n < 2; ++n) _Pragma("unroll") for (int k = 0; k < 2; ++k) \
        acc[ai][bj][m][n] = __builtin_amdgcn_mfma_f32_16x16x32_bf16(Bt[n][k], At[m][k], acc[ai][bj][m][n], 0, 0, 0); __builtin_amdgcn_s_setprio(0); } while (0)
#define PG8_WAIT_V(n) asm volatile("s_waitcnt vmcnt(" #n ")" ::: "memory")
#define PG8_WAIT_L(n) asm volatile("s_waitcnt lgkmcnt(" #n ")" ::: "memory")
#define PG8_BAR __builtin_amdgcn_s_barrier()
#define PG8_SCHED __builtin_amdgcn_sched_barrier(0)
    Unit cur, nxt; int ui = 0;
    if (!S.next(0, cur)) return;
    f32x4 acc[2][2][4][2];
#pragma unroll
    for (int a = 0; a < 2; ++a)
#pragma unroll
        for (int b = 0; b < 2; ++b)
#pragma unroll
            for (int m = 0; m < 4; ++m)
#pragma unroll
                for (int n = 0; n < 2; ++n) acc[a][b][m][n] = (f32x4){0.f, 0.f, 0.f, 0.f};
    bf16x8 At[4][2], B0[2][2], B1[2][2];
    const char* cA = (const char*)g.A + (size_t)cur.pm * tstepA + (long long)cur.g * g.gstepA + (size_t)cur.kt0 * (BK * 2); const char* cB = (const char*)g.Bt + (size_t)cur.pn * tstepB + (long long)cur.g * g.gstepB + (size_t)cur.kt0 * (BK * 2);
    S.a_ready(cur);
    PG8_STAGE(PG8_SB(0, 0), cB, voffB); PG8_STAGE(PG8_SB(0, 1), cB + hstepB, voffB); PG8_STAGE(PG8_SA(0, 0), cA, voffA); PG8_STAGE(PG8_SA(0, 1), cA + hstepA, voffA);
    if (wr == 1) PG8_BAR;
    PG8_WAIT_V(2); PG8_BAR;
    PG8_STAGE(PG8_SB(1, 0), cB + kstep, voffB); PG8_STAGE(PG8_SA(1, 0), cA + kstep, voffA); PG8_STAGE(PG8_SB(1, 1), cB + hstepB + kstep, voffB);
    PG8_WAIT_V(6); PG8_BAR;
    for (;;) {
        const bool has_next = S.next(ui + 1, nxt);
        const char* nA = has_next ? (const char*)g.A + (size_t)nxt.pm * tstepA + (long long)nxt.g * g.gstepA + (size_t)nxt.kt0 * (BK * 2) : cA; const char* nB = has_next ? (const char*)g.Bt + (size_t)nxt.pn * tstepB + (long long)nxt.g * g.gstepB + (size_t)nxt.kt0 * (BK * 2) : cB;
        const int nt = cur.ktn ? cur.ktn : ntK;
        for (int t = 0; t < nt; t += 2) {
            const bool last = (t == nt - 2);
            const char* a1 = cA + (size_t)(t + 1) * kstep;
            const char* a2 = last ? nA : cA + (size_t)(t + 2) * kstep; const char* b2 = last ? nB : cB + (size_t)(t + 2) * kstep;
            const char* a3 = a2 + kstep; const char* b3 = b2 + kstep;
            if (last && has_next) S.a_ready(nxt);
            PG8_LDB(B0, 0, 0); PG8_LDB(B1, 0, 1); PG8_SCHED; PG8_LDA(At, 0, 0); PG8_STAGE(PG8_SA(1, 1), a1 + hstepA, voffA);
            PG8_WAIT_V(8); PG8_WAIT_L(0); PG8_BAR; PG8_MMA(0, 0, At, B0); PG8_MMA(0, 1, At, B1); PG8_BAR; PG8_SCHED;
            PG8_LDA(At, 0, 1); PG8_STAGE(PG8_SB(0, 0), b2, voffB); PG8_STAGE(PG8_SB(0, 1), b2 + hstepB, voffB); PG8_STAGE(PG8_SA(0, 0), a2, voffA);
            PG8_WAIT_V(8); PG8_WAIT_L(0); PG8_BAR; PG8_MMA(1, 0, At, B0); PG8_MMA(1, 1, At, B1); PG8_BAR; PG8_SCHED;
            PG8_LDB(B0, 1, 0); PG8_LDB(B1, 1, 1); PG8_SCHED; PG8_LDA(At, 1, 0); PG8_STAGE(PG8_SA(0, 1), a2 + hstepA, voffA);
            PG8_WAIT_V(8); PG8_WAIT_L(0); PG8_BAR; PG8_MMA(0, 0, At, B0); PG8_MMA(0, 1, At, B1); PG8_BAR; PG8_SCHED;
            PG8_LDA(At, 1, 1); PG8_STAGE(PG8_SB(1, 0), b3, voffB); PG8_STAGE(PG8_SB(1, 1), b3 + hstepB, voffB); PG8_STAGE(PG8_SA(1, 0), a3, voffA);
            PG8_WAIT_V(8); PG8_WAIT_L(0); PG8_BAR; PG8_MMA(1, 0, At, B0); PG8_MMA(1, 1, At, B1); PG8_BAR; PG8_SCHED;
        }
        if constexpr (ALIGN_EPI) { if (wr == 0) PG8_BAR; }
        E(acc, cur, wr, wc, fr, fq); S.done(cur);
        if (!has_next) break;
#pragma unroll
        for (int a = 0; a < 2; ++a)
#pragma unroll
            for (int b = 0; b < 2; ++b)
#pragma unroll
                for (int m = 0; m < 4; ++m)
#pragma unroll
                    for (int n = 0; n < 2; ++n) acc[a][b][m][n] = (f32x4){0.f, 0.f, 0.f, 0.f};
        cur = nxt; cA = nA; cB = nB; ++ui;
        if constexpr (ALIGN_EPI) { if (wr == 1) PG8_BAR; }
    }
    PG8_WAIT_V(0);
    if constexpr (!ALIGN_EPI) { if (wr == 0) PG8_BAR; }
    PG8_BAR;
#undef PG8_SA
#undef PG8_SB
#undef PG8_STAGE
#undef PG8_LDA
#undef PG8_LDB
#undef PG8_MMA
#undef PG8_WAIT_V
#undef PG8_WAIT_L
#undef PG8_BAR
#undef PG8_SCHED
}
}


#define XB_TMO      128
#define XB_XCNT(j)  (256  + 64 * (j))
#define XB_XSUB(j)  (1280 + 64 * (j))
#define XB_XGEN(j)  (2304 + 64 * (j))
#define XB_TOP      3328
#define XB_TOPGEN   3392
#define XCD_BAR_WORDS 3456
#define XB_SPIN_CAP (1u << 18)
__device__ __forceinline__ unsigned xb_ld(unsigned* p)              { return __hip_atomic_load(p, __ATOMIC_RELAXED, __HIP_MEMORY_SCOPE_AGENT); }
__device__ __forceinline__ unsigned xb_add(unsigned* p, unsigned v) { return __hip_atomic_fetch_add(p, v, __ATOMIC_RELAXED, __HIP_MEMORY_SCOPE_AGENT); }
__device__ __forceinline__ unsigned xb_xcc_id() { return (unsigned)__builtin_amdgcn_s_getreg((3 << 11) | 20) & 0xFu; }
#define XB_SPIN(cond, bar) do { unsigned _sp = 0; while (cond) { __builtin_amdgcn_s_sleep(1); \
    if ((++_sp & 255u) == 0u) { if (xb_ld(&(bar)[XB_TMO])) break; if (_sp > XB_SPIN_CAP) { atomicAdd(&(bar)[XB_TMO], 1u); break; } } } } while (0)
struct XcdBarrier { unsigned* bar; unsigned x; volatile LAS unsigned* st; };
__device__ __forceinline__ XcdBarrier xcd_barrier_post(unsigned* bar, volatile LAS unsigned* st, bool t0) {
    XcdBarrier b; b.bar = bar; b.x = xb_xcc_id(); b.st = st;
    if (t0) (void)xb_add(&bar[XB_XCNT(b.x)], 1u);
    return b;
}
__device__ __forceinline__ void xcd_barrier_complete(unsigned* bar, unsigned x, unsigned& nloc, unsigned& nx) {
    const unsigned G = gridDim.x * gridDim.y * gridDim.z;
    unsigned sum, cnt, mine, sp = 0u;
    for (;;) {
        sum = 0u; cnt = 0u; mine = 0u;
#pragma unroll
        for (unsigned j = 0; j < 16; ++j) { const unsigned c = xb_ld(&bar[XB_XCNT(j)]); sum += c; cnt += (c > 0u) ? 1u : 0u; mine = (j == x) ? c : mine; }
        if (sum == G) break;
        __builtin_amdgcn_s_sleep(1);
        if ((++sp & 255u) == 0u) { if (xb_ld(&bar[XB_TMO])) break; if (sp > XB_SPIN_CAP) { atomicAdd(&bar[XB_TMO], 1u); break; } }
    }
    nloc = mine > 0u ? mine : 1u; nx = cnt > 0u ? cnt : 1u;
}
__device__ __forceinline__ void xcd_barrier(const XcdBarrier& b, bool t0) {
    asm volatile("s_waitcnt vmcnt(0)" ::: "memory");
    __syncthreads();
    if (t0) {
        unsigned* bar = b.bar;
        __builtin_amdgcn_s_waitcnt(0);
        unsigned nloc = b.st[0], nx = b.st[1];
        if (nloc == 0u) { xcd_barrier_complete(bar, b.x, nloc, nx); b.st[0] = nloc; b.st[1] = nx; }
        const unsigned old = xb_add(&bar[XB_XSUB(b.x)], 1u);
        const unsigned gen = old / nloc;
        if (old + 1u == (gen + 1u) * nloc) {
            __builtin_amdgcn_fence(__ATOMIC_RELEASE, "agent");
            asm volatile("s_waitcnt vmcnt(0)" ::: "memory");
            const unsigned og = xb_add(&bar[XB_TOP], 1u);
            const unsigned tg = og / nx;
            if (og + 1u == (tg + 1u) * nx) xb_add(&bar[XB_TOPGEN], 1u);
            else XB_SPIN(xb_ld(&bar[XB_TOPGEN]) == tg, bar);
            __builtin_amdgcn_fence(__ATOMIC_ACQUIRE, "agent");
            xb_add(&bar[XB_XGEN(b.x)], 1u);
            asm volatile("s_waitcnt vmcnt(0)" ::: "memory");
        } else {
            XB_SPIN(xb_ld(&bar[XB_XGEN(b.x)]) == gen, bar);
            __builtin_amdgcn_fence(__ATOMIC_ACQUIRE, "agent");
            asm volatile("s_waitcnt vmcnt(0)" ::: "memory");
        }
    }
    __syncthreads();
}

__device__ __forceinline__ void transpose_item(const float* W, int K, int N, bf16* WT, bool gu, LAS float* scr, int item, int lane) {
    const int nblk = N / 64, kb = item / nblk, nb = item % nblk, k0 = 64 * kb, n0 = 64 * nb;
    int r0 = n0; bool qk = false;
    float wsc = 1.0f;
    if (gu) { const int jj = (n0 < DFF) ? n0 : n0 - DFF; r0 = (jj >> 7) * 256 + (jj & 127) + ((n0 < DFF) ? 0 : 128); wsc = (n0 < DFF) ? 1.44269504089f : 0.69314718056f; }
    if (N == 3072 && n0 < 2048) { qk = true; const int hc = n0 >> 6; r0 = (hc >> 2) * 256 + (hc & 3) * 32; }
    const int n4 = lane & 15, kr = lane >> 4;
    const float* wp = W + (size_t)(k0 + kr) * N + n0 + 4 * n4;
    f32x4 v[16];
#pragma unroll
    for (int i = 0; i < 16; ++i) v[i] = *(const f32x4*)(wp + (size_t)(4 * i) * N);
#pragma unroll
    for (int i = 0; i < 16; ++i) { LAS float* d = scr + (4 * i + kr) * 65 + 4 * n4; d[0] = v[i].x; d[1] = v[i].y; d[2] = v[i].z; d[3] = v[i].w; }
    asm volatile("s_waitcnt lgkmcnt(0)" ::: "memory");
    const int c = lane & 7;
#pragma unroll
    for (int j = 0; j < 8; ++j) { const int n = (lane >> 3) + 8 * j; const LAS float* q = scr + (8 * c) * 65 + n;
        u32x4 o; o.x = pk2(q[0 * 65] * wsc, q[1 * 65] * wsc); o.y = pk2(q[2 * 65] * wsc, q[3 * 65] * wsc); o.z = pk2(q[4 * 65] * wsc, q[5 * 65] * wsc); o.w = pk2(q[6 * 65] * wsc, q[7 * 65] * wsc);
        *(u32x4*)(WT + (size_t)(qk ? (r0 + (n >> 5) * 128 + (n & 31)) : (r0 + n)) * K + k0 + 8 * c) = o; }
    asm volatile("s_waitcnt lgkmcnt(0)" ::: "memory");
}


__device__ __forceinline__ void norm_phase(const float* xsrc, const float* ysrc, const float* ysrc2, const float* gvec, const float* ada, int kshift, bf16* hb, bool with_ctx, int vcu, int NGW, int wv) {
    const int tid = wv * 64 + lane_id_v(); asm volatile("" : "+s"(vcu), "+s"(NGW));
    const int lane = tid & 63, gw = vcu * 8 + __builtin_amdgcn_readfirstlane(tid >> 6);
    const int nrows = with_ctx ? MC : MX, rpw = (nrows + NGW - 1) / NGW, r0 = gw * rpw;
    int prev_s = -1; f32x4 gsv[4], shv[4], vn[4];
#define NORM_ROWPOS(i_, b_, j_) do { if (with_ctx) { b_ = (i_) / TOK; j_ = (i_) % TOK; } else { b_ = (i_) >> 11; j_ = 256 + ((i_) & 2047); } } while (0)
#define NORM_LOAD(i_, dst_) do { int b_, j_; NORM_ROWPOS(i_, b_, j_); \
        if (j_ < CTX) { const f32x4* p_ = (const f32x4*)(ysrc + ((size_t)b_ * CTX + j_) * DM) + lane; _Pragma("unroll") for (int q = 0; q < 4; ++q) dst_[q] = p_[64 * q]; \
            if (ysrc2) { const f32x4* p2_ = (const f32x4*)(ysrc2 + ((size_t)b_ * CTX + j_) * DM) + lane; _Pragma("unroll") for (int q = 0; q < 4; ++q) dst_[q] += p2_[64 * q]; } } \
        else { const f32x4* p_ = (const f32x4*)(xsrc + ((size_t)b_ * SEQ + (j_ - CTX)) * DM) + lane; _Pragma("unroll") for (int q = 0; q < 4; ++q) dst_[q] = p_[64 * q]; } } while (0)
    if (r0 < nrows) NORM_LOAD(r0, vn);
    for (int k = 0; k < rpw; ++k) {
        const int i = r0 + k; if (i >= nrows) break;
        f32x4 v[4];
#pragma unroll
        for (int q = 0; q < 4; ++q) v[q] = vn[q];
        if (k + 1 < rpw && i + 1 < nrows) NORM_LOAD(i + 1, vn);
        int b, j; NORM_ROWPOS(i, b, j);
        const int s = (j < CTX) ? 16 : b;
        if (s != prev_s) { prev_s = s;
            const f32x4* gp = (const f32x4*)gvec + lane; const f32x4* shp = (const f32x4*)(ada + (size_t)(s * 9 + kshift) * DM) + lane; const f32x4* scp = shp + DM / 4;
#pragma unroll
            for (int q = 0; q < 4; ++q) { gsv[q] = gp[64 * q] * (scp[64 * q] + 1.0f); shv[q] = shp[64 * q]; } }
        float ss = 0.f;
#pragma unroll
        for (int q = 0; q < 4; ++q) ss += (v[q].x * v[q].x + v[q].y * v[q].y) + (v[q].z * v[q].z + v[q].w * v[q].w);
        const float rstd = rsqrtf(wave_sum(ss) * (1.f / DM) + EPS);
        u32x2* o8 = (u32x2*)(hb + ((size_t)b * TOK + j) * DM) + lane;
#pragma unroll
        for (int q = 0; q < 4; ++q) { const f32x4 o = v[q] * rstd * gsv[q] + shv[q];
            u32x2 w; w.x = pk2(o.x, o.y); w.y = pk2(o.z, o.w); o8[64 * q] = w; }
    }
#undef NORM_LOAD
#undef NORM_ROWPOS
}

__device__ __forceinline__ void norm_fourier_phase(const float* xsrc, const float* gvec, const float* ada, bf16* hb, float* h1024, int vcu, int NGW, int wv) {
    const int tid = wv * 64 + lane_id_v(); asm volatile("" : "+s"(vcu), "+s"(NGW));
    const int lane = tid & 63, gw = vcu * 8 + __builtin_amdgcn_readfirstlane(tid >> 6);
    const int nit = NB * 1024, ipw = (nit + NGW - 1) / NGW, i0 = gw * ipw;
    int prev_b = -1; f32x4 gsv[4], shv[4], na[4], nb[4];
#define NF_LOAD(i_) do { const int b_ = (i_) >> 10, p_ = (i_) & 1023, p2_ = p_ ? (SEQ - p_) : (SEQ / 2); \
        const f32x4* xa_ = (const f32x4*)(xsrc + ((size_t)b_ * SEQ + p_) * DM) + lane; const f32x4* xb_ = (const f32x4*)(xsrc + ((size_t)b_ * SEQ + p2_) * DM) + lane; \
        _Pragma("unroll") for (int q = 0; q < 4; ++q) { na[q] = xa_[64 * q]; nb[q] = xb_[64 * q]; } } while (0)
    if (i0 < nit) NF_LOAD(i0);
    for (int k = 0; k < ipw; ++k) {
        const int i = i0 + k; if (i >= nit) break;
        const int b = i >> 10, p = i & 1023;
        f32x4 va[4], vb[4];
#pragma unroll
        for (int q = 0; q < 4; ++q) { va[q] = na[q]; vb[q] = nb[q]; }
        if (k + 1 < ipw && i + 1 < nit) NF_LOAD(i + 1);
        if (b != prev_b) { prev_b = b;
            const f32x4* gp = (const f32x4*)gvec + lane; const f32x4* shp = (const f32x4*)(ada + (size_t)(b * 9 + 3) * DM) + lane; const f32x4* scp = shp + DM / 4;
#pragma unroll
            for (int q = 0; q < 4; ++q) { gsv[q] = gp[64 * q] * (scp[64 * q] + 1.0f); shv[q] = shp[64 * q]; } }
        float sa = 0.f, sb = 0.f;
#pragma unroll
        for (int q = 0; q < 4; ++q) { sa += (va[q].x * va[q].x + va[q].y * va[q].y) + (va[q].z * va[q].z + va[q].w * va[q].w); sb += (vb[q].x * vb[q].x + vb[q].y * vb[q].y) + (vb[q].z * vb[q].z + vb[q].w * vb[q].w); }
        const float ra = rsqrtf(wave_sum(sa) * (1.f / DM) + EPS), rb = rsqrtf(wave_sum(sb) * (1.f / DM) + EPS);
        u32x2* oe = (u32x2*)(hb + ((size_t)b * TOK + CTX + p) * DM) + lane; u32x2* oo = (u32x2*)(hb + ((size_t)b * TOK + CTX + 1024 + p) * DM) + lane;
        f32x4* hs = (f32x4*)(h1024 + (size_t)b * DM) + lane;
#pragma unroll
        for (int q = 0; q < 4; ++q) { const f32x4 ha = va[q] * ra * gsv[q] + shv[q], hbv = vb[q] * rb * gsv[q] + shv[q];
            f32x4 e, o;
            if (p) { e = ha + hbv; o = ha - hbv; } else { e = ha; o = (f32x4){0.f, 0.f, 0.f, 0.f}; hs[64 * q] = hbv; }
            u32x2 we, wo; we.x = pk2(e.x, e.y); we.y = pk2(e.z, e.w); wo.x = pk2(o.x, o.y); wo.y = pk2(o.z, o.w);
            oe[64 * q] = we; oo[64 * q] = wo; }
    }
#undef NF_LOAD
}

__device__ __forceinline__ void ada_phase(LAS unsigned char* lds, const float* c, const float* c_ctx, const float* w_mod, const float* b_mod, float* ada, int G, int bid, int wv) {
    const int tid = wv * 64 + lane_id_v();
    LAS float* sc = (LAS float*)lds;
    LAS float* red = (LAS float*)(lds + 17 * 1024 * 4);
    {
        float cv[34];
#pragma unroll
        for (int q = 0; q < 34; ++q) { const int i = tid + 512 * q, s = i >> 10, k = i & 1023; cv[q] = (s < 16) ? c[s * 1024 + k] : c_ctx[k]; }
#pragma unroll
        for (int q = 0; q < 34; ++q) sc[tid + 512 * q] = cv[q] / (1.0f + __expf(-cv[q]));
    }
    __syncthreads();
    const int lane = tid & 63, w = tid >> 6, n4 = lane & 15, kr = lane >> 4;
    for (int item = bid; item < 288; item += G) {
        const int layer = item / 144, c0 = (item % 144) * 64;
        const float* W = w_mod + (size_t)layer * 1024 * NMOD + (size_t)(w * 128 + kr) * NMOD + c0 + 4 * n4;
        const LAS float* scp = sc + w * 128 + kr;
        f32x4 acc[17];
#pragma unroll
        for (int s = 0; s < 17; ++s) acc[s] = (f32x4){0.f, 0.f, 0.f, 0.f};
        for (int st0 = 0; st0 < 32; st0 += 8) {
            f32x4 wv[8];
#pragma unroll
            for (int u = 0; u < 8; ++u) wv[u] = *(const f32x4*)(W + (size_t)(4 * (st0 + u)) * NMOD);
#pragma unroll
            for (int u = 0; u < 8; ++u) {
#pragma unroll
                for (int s = 0; s < 17; ++s) acc[s] += wv[u] * scp[s * 1024 + 4 * (st0 + u)];
                __builtin_amdgcn_sched_barrier(0); } }
#pragma unroll
        for (int s = 0; s < 17; ++s)
#pragma unroll
            for (int e = 0; e < 4; ++e) { float v = acc[s][e]; v += __shfl_xor(v, 16); v += __shfl_xor(v, 32); if (lane < 16) red[(w * 17 + s) * 64 + 4 * n4 + e] = v; }
        __syncthreads();
        for (int o = tid; o < 17 * 64; o += 512) { const int s = o >> 6, cc = o & 63; float sum = 0.f;
#pragma unroll
            for (int q = 0; q < 8; ++q) sum += red[(q * 17 + s) * 64 + cc];
            ada[(size_t)(layer * 17 + s) * NMOD + c0 + cc] = sum + b_mod[layer * NMOD + c0 + cc]; }
        __syncthreads();
    }
}

__device__ __forceinline__ void qknorm_phase(bf16* Qr, bf16* Kr, const float* qg, const float* kg, const f32x2* rope, int vcu, int NGW, int wv) {
    const int tid = wv * 64 + lane_id_v(); asm volatile("" : "+s"(vcu), "+s"(NGW));
    const int lane = tid & 63, gw = vcu * 8 + __builtin_amdgcn_readfirstlane(tid >> 6);
    for (int it = gw; it < MC * 2; it += NGW) {
        const int r = it >> 1, which = it & 1, b = r / TOK, j = r % TOK;
        if (j < CTX && which == 0) continue;
        bf16* p = (which ? Kr : Qr) + (size_t)r * DM + lane * 16;
        const u32x4 w0 = *(const u32x4*)p, w1 = *(const u32x4*)(p + 8);
        float v[16];
        v[0] = bf_lo(w0.x); v[1] = bf_hi(w0.x); v[2] = bf_lo(w0.y); v[3] = bf_hi(w0.y); v[4] = bf_lo(w0.z); v[5] = bf_hi(w0.z); v[6] = bf_lo(w0.w); v[7] = bf_hi(w0.w);
        v[8] = bf_lo(w1.x); v[9] = bf_hi(w1.x); v[10] = bf_lo(w1.y); v[11] = bf_hi(w1.y); v[12] = bf_lo(w1.z); v[13] = bf_hi(w1.z); v[14] = bf_lo(w1.w); v[15] = bf_hi(w1.w);
        float ss = 0.f;
#pragma unroll
        for (int i = 0; i < 16; ++i) ss += v[i] * v[i];
        ss += shx<1>(ss); ss += shx<2>(ss);
        const float rstd = rsqrtf(ss * (1.f / 64.f) + EPS);
        const float* gn = (which ? kg : qg) + (lane & 3) * 16;
#pragma unroll
        for (int i = 0; i < 16; ++i) v[i] = v[i] * rstd * gn[i];
        if (j >= CTX) {
            const int pos = j - CTX, axis = (lane >> 1) & 1, half = lane & 1;
            const f32x2* cs = rope + ((size_t)pos * 2 + axis) * 16;
#pragma unroll
            for (int i = 0; i < 16; ++i) { const float pv = shx<1>(v[i]); const f32x2 t = cs[i];
                v[i] = half ? (v[i] * t.x + pv * t.y) : (v[i] * t.x - pv * t.y); }
        }
        if (which == 0) {
#pragma unroll
            for (int i = 0; i < 16; ++i) v[i] *= QSCALE;
        }
        u32x4 o0, o1;
        o0.x = pk2(v[0], v[1]); o0.y = pk2(v[2], v[3]); o0.z = pk2(v[4], v[5]); o0.w = pk2(v[6], v[7]);
        o1.x = pk2(v[8], v[9]); o1.y = pk2(v[10], v[11]); o1.z = pk2(v[12], v[13]); o1.w = pk2(v[14], v[15]);
        *(u32x4*)p = o0; *(u32x4*)(p + 8) = o1;
    }
}

constexpr int AT_ROW = 144, AT_SLOT = 128 * AT_ROW  , AT_K = 0, AT_V = 3 * AT_SLOT  , AT_X = 0, AT_OUT = 5 * AT_SLOT  , AT_OROW = 272;
__device__ __forceinline__ int crow(int i, int h) { return (i & 3) + 8 * (i >> 2) + 4 * h; }
#define MFMA32(a, b, c) __builtin_amdgcn_mfma_f32_32x32x16_bf16((a), (b), (c), 0, 0, 0)
__device__ __forceinline__ void attn_phase(LAS unsigned char* lds, const bf16* Q, const bf16* Kt, const bf16* VT, bf16* O, float out_scale, int G, int bid, int wv) {
    const int tid = wv * 64 + lane_id_v();
    const int lane = tid & 63, r = lane & 31, h = lane >> 5, wid = __builtin_amdgcn_readfirstlane(tid >> 6), c = wid & 1, qg = wid >> 1;
    asm volatile("" : "+s"(bid), "+s"(G));
    const int vcu = (G % 8 == 0) ? (bid % 8) * (G / 8) + bid / 8 : bid;
    const int srow2 = (tid & 255) >> 3, spart = tid & 7; const bool lead = wid < 4;
    const int rsw = (r & 19) | ((r & 4) << 1) | ((r & 8) >> 1);
    const int koff = AT_K + (c * 64 + rsw) * AT_ROW + h * 16, voff = AT_V + r * AT_ROW + h * 16;
    const int sdst = srow2 * AT_ROW + spart * 16;
    constexpr int NT = TOK / 64;
    f32x16 zero16;
#pragma unroll
    for (int i = 0; i < 16; ++i) zero16[i] = 0.f;
#define AT_BAR() do { asm volatile("s_waitcnt lgkmcnt(0)" ::: "memory"); __builtin_amdgcn_s_barrier(); asm volatile("" ::: "memory"); } while (0)
    for (int unit = vcu; unit < NB * 8 * 16; unit += G) {
        const int bh = unit >> 4, qb = unit & 15, b = bh >> 3, hh = bh & 7, q0 = qb * 128;
        const bf16* qp = Q + ((size_t)b * TOK + CTX + q0 + qg * 32 + r) * DM + hh * 128 + c * 64 + h * 8;
        bf16x8 qf[4];
#pragma unroll
        for (int d0 = 0; d0 < 4; ++d0) qf[d0] = *(const bf16x8*)(qp + d0 * 16);
        const bf16* g0 = lead ? Kt + ((size_t)b * TOK + srow2) * DM + hh * 128 + spart * 8 : VT + ((size_t)(b * 1024 + hh * 128 + srow2)) * TOK + spart * 8;
        const size_t go1 = lead ? (size_t)32 * DM : (size_t)32 * TOK, go2 = lead ? (size_t)64 : (size_t)64 * TOK, go3 = go1 + go2;
        const int gstep = lead ? 64 * DM : 64;
        f32x16 o[4];
#pragma unroll
        for (int d = 0; d < 4; ++d)
#pragma unroll
            for (int i = 0; i < 16; ++i) o[d][i] = 0.f;
        float lsum0 = 0.f, lsum1 = 0.f;
        u32x4 st[4];
        {
            const u32x4 a0 = *(const u32x4*)(g0), a1 = *(const u32x4*)(g0 + go1), a2 = *(const u32x4*)(g0 + go2), a3 = *(const u32x4*)(g0 + go3);
            const int d0 = (lead ? AT_K : AT_V) + sdst;
            *(LAS u32x4*)(lds + d0) = a0; *(LAS u32x4*)(lds + d0 + 32 * AT_ROW) = a1; *(LAS u32x4*)(lds + d0 + 64 * AT_ROW) = a2; *(LAS u32x4*)(lds + d0 + 96 * AT_ROW) = a3;
            if (lead) { const bf16* g1 = g0 + gstep; const u32x4 b0 = *(const u32x4*)(g1), b1 = *(const u32x4*)(g1 + go1), b2 = *(const u32x4*)(g1 + go2), b3 = *(const u32x4*)(g1 + go3);
                const int d1 = AT_K + AT_SLOT + sdst;
                *(LAS u32x4*)(lds + d1) = b0; *(LAS u32x4*)(lds + d1 + 32 * AT_ROW) = b1; *(LAS u32x4*)(lds + d1 + 64 * AT_ROW) = b2; *(LAS u32x4*)(lds + d1 + 96 * AT_ROW) = b3; }
        }
        __syncthreads();
        f32x16 sc0, sc1, sn0, sn1;
        {
            sc0 = zero16; sc1 = zero16;
#pragma unroll
            for (int d0 = 0; d0 < 4; ++d0) { const bf16x8 k0 = *(const LAS bf16x8*)(lds + koff + d0 * 32), k1 = *(const LAS bf16x8*)(lds + koff + 32 * AT_ROW + d0 * 32);
                sc0 = MFMA32(k0, qf[d0], sc0); sc1 = MFMA32(k1, qf[d0], sc1); }
        }
        if (!lead) AT_BAR();
        int ks_next = AT_SLOT, ks_fill = 2 * AT_SLOT;
#define SEQ_MV __builtin_amdgcn_sched_group_barrier(0x100, 4, 0); _Pragma("unroll") for (int q = 0; q < 4; ++q) { __builtin_amdgcn_sched_group_barrier(0x8, 1, 0); __builtin_amdgcn_sched_group_barrier(0x100, 1, 0); __builtin_amdgcn_sched_group_barrier(0x402, 5, 0); } _Pragma("unroll") for (int q = 0; q < 4; ++q) { __builtin_amdgcn_sched_group_barrier(0x8, 1, 0); __builtin_amdgcn_sched_group_barrier(0x402, 5, 0); }
#define SEQ_M __builtin_amdgcn_sched_group_barrier(0x100, 4, 0); _Pragma("unroll") for (int q = 0; q < 4; ++q) { __builtin_amdgcn_sched_group_barrier(0x8, 1, 0); __builtin_amdgcn_sched_group_barrier(0x100, 1, 0); } __builtin_amdgcn_sched_group_barrier(0x8, 4, 0);
#define ADDS(acc_, x_) asm("v_add_f32_e32 %0, %1, %0" : "+v"(acc_) : "v"(x_))
#define ATT_BODY(HAS_NEXT, C0, C1, N0, N1) do { \
            const int vs = (t & 1) * AT_SLOT; \
            if (HAS_NEXT) { const int tk = lead ? ((t + 2 < NT) ? t + 2 : NT - 1) : t + 1; const bf16* g = g0 + (size_t)tk * gstep; \
                st[0] = *(const u32x4*)(g); st[1] = *(const u32x4*)(g + go1); st[2] = *(const u32x4*)(g + go2); st[3] = *(const u32x4*)(g + go3); } \
            bf16x8 pf[2][2]; \
            {   \
                bf16x8 kf[2][4]; \
                if (HAS_NEXT) { _Pragma("unroll") for (int d0 = 0; d0 < 4; ++d0) { kf[0][d0] = *(const LAS bf16x8*)(lds + ks_next + koff + d0 * 32); kf[1][d0] = *(const LAS bf16x8*)(lds + ks_next + koff + 32 * AT_ROW + d0 * 32); } \
                    N0 = MFMA32(kf[0][0], qf[0], zero16); N1 = MFMA32(kf[1][0], qf[0], zero16); \
                    _Pragma("unroll") for (int d0 = 1; d0 < 4; ++d0) { N0 = MFMA32(kf[0][d0], qf[d0], N0); N1 = MFMA32(kf[1][d0], qf[d0], N1); } } \
                _Pragma("unroll") for (int i = 0; i < 16; i += 2) { C0[i] = __builtin_amdgcn_exp2f(C0[i]); C0[i + 1] = __builtin_amdgcn_exp2f(C0[i + 1]); ADDS(lsum0, C0[i]); ADDS(lsum1, C0[i + 1]); } \
                _Pragma("unroll") for (int sx = 0; sx < 2; ++sx) { u32x4 w; w.x = pk2(C0[8 * sx], C0[8 * sx + 1]); w.y = pk2(C0[8 * sx + 2], C0[8 * sx + 3]); w.z = pk2(C0[8 * sx + 4], C0[8 * sx + 5]); w.w = pk2(C0[8 * sx + 6], C0[8 * sx + 7]); pf[0][sx] = __builtin_bit_cast(bf16x8, w); } \
                if (HAS_NEXT) { SEQ_MV } \
            } \
            __builtin_amdgcn_sched_barrier(0); \
            AT_BAR(); \
            {   \
                bf16x8 vf[4][2]; \
                _Pragma("unroll") for (int sx = 0; sx < 2; ++sx) _Pragma("unroll") for (int dvb = 0; dvb < 4; ++dvb) vf[dvb][sx] = *(const LAS bf16x8*)(lds + vs + voff + dvb * 32 * AT_ROW + sx * 32); \
                _Pragma("unroll") for (int sx = 0; sx < 2; ++sx) _Pragma("unroll") for (int dvb = 0; dvb < 4; ++dvb) o[dvb] = MFMA32(vf[dvb][sx], pf[0][sx], o[dvb]); \
                _Pragma("unroll") for (int i = 0; i < 16; i += 2) { C1[i] = __builtin_amdgcn_exp2f(C1[i]); C1[i + 1] = __builtin_amdgcn_exp2f(C1[i + 1]); ADDS(lsum0, C1[i]); ADDS(lsum1, C1[i + 1]); } \
                _Pragma("unroll") for (int sx = 0; sx < 2; ++sx) { u32x4 w; w.x = pk2(C1[8 * sx], C1[8 * sx + 1]); w.y = pk2(C1[8 * sx + 2], C1[8 * sx + 3]); w.z = pk2(C1[8 * sx + 4], C1[8 * sx + 5]); w.w = pk2(C1[8 * sx + 6], C1[8 * sx + 7]); pf[1][sx] = __builtin_bit_cast(bf16x8, w); } \
                SEQ_MV \
            } \
            __builtin_amdgcn_sched_barrier(0); \
            {   \
                bf16x8 vf[4][2]; \
                _Pragma("unroll") for (int sx = 0; sx < 2; ++sx) _Pragma("unroll") for (int dvb = 0; dvb < 4; ++dvb) vf[dvb][sx] = *(const LAS bf16x8*)(lds + vs + voff + dvb * 32 * AT_ROW + 64 + sx * 32); \
                _Pragma("unroll") for (int sx = 0; sx < 2; ++sx) _Pragma("unroll") for (int dvb = 0; dvb < 4; ++dvb) o[dvb] = MFMA32(vf[dvb][sx], pf[1][sx], o[dvb]); \
                SEQ_M \
            } \
            if (HAS_NEXT) { const int dd = (lead ? ks_fill : AT_V + (AT_SLOT - vs)) + sdst; \
                *(LAS u32x4*)(lds + dd) = st[0]; *(LAS u32x4*)(lds + dd + 32 * AT_ROW) = st[1]; *(LAS u32x4*)(lds + dd + 64 * AT_ROW) = st[2]; *(LAS u32x4*)(lds + dd + 96 * AT_ROW) = st[3]; } \
            AT_BAR(); \
            if (HAS_NEXT) { const int tmp = ks_next; ks_next = ks_fill; ks_fill = (tmp == 0) ? 2 * AT_SLOT : tmp - AT_SLOT; } \
        } while (0)
        int t = 0;
        for (; t < NT - 2; t += 2) { ATT_BODY(true, sc0, sc1, sn0, sn1); ++t; ATT_BODY(true, sn0, sn1, sc0, sc1); --t; }
        ATT_BODY(true, sc0, sc1, sn0, sn1); ++t;
        ATT_BODY(false, sn0, sn1, sc0, sc1);
#undef ATT_BODY
#undef ADDS
#undef SEQ_MV
#undef SEQ_M
        if (lead) AT_BAR();
        const float lsum = lsum0 + lsum1;
        KArgs ka = KA(); const float lam = P_SCAL[0]; const float* sub_g = ka->in[19];
        const float l = add_x32(lsum);
        LAS float* X = (LAS float*)(lds + AT_X);
        if (c == 1) { const float f = lam / l;
#pragma unroll
            for (int dvb = 0; dvb < 4; ++dvb)
#pragma unroll
                for (int i = 0; i < 16; ++i) X[(qg * 128 + dvb * 32 + crow(i, h)) * 32 + r] = o[dvb][i] * f; }
        __syncthreads();
        if (c == 0) { const float f = 1.0f / l; float ss = 0.f;
#pragma unroll
            for (int dvb = 0; dvb < 4; ++dvb)
#pragma unroll
                for (int i = 0; i < 16; ++i) { const float v = o[dvb][i] * f - X[(qg * 128 + dvb * 32 + crow(i, h)) * 32 + r]; o[dvb][i] = v; ss += v * v; }
            ss = add_x32(ss);
            const float rstd = rsqrtf(ss * (1.f / 128.f) + EPS) * out_scale;
#pragma unroll
            for (int dvb = 0; dvb < 4; ++dvb)
#pragma unroll
                for (int i4 = 0; i4 < 4; ++i4) { const int dv = dvb * 32 + 8 * i4 + 4 * h; const f32x4 sg = *(const f32x4*)(sub_g + dv);
                    u32x2 w; w.x = pk2(o[dvb][4 * i4] * rstd * sg.x, o[dvb][4 * i4 + 1] * rstd * sg.y); w.y = pk2(o[dvb][4 * i4 + 2] * rstd * sg.z, o[dvb][4 * i4 + 3] * rstd * sg.w);
                    *(LAS u32x2*)(lds + AT_OUT + (qg * 32 + r) * AT_OROW + dv * 2) = w; } }
        __syncthreads();
#pragma unroll
        for (int i = 0; i < 4; ++i) { const int ch = tid + 512 * i, row = ch >> 4, part = ch & 15;
            const u32x4 v = *(const LAS u32x4*)(lds + AT_OUT + row * AT_OROW + part * 16);
            *(u32x4*)(O + ((size_t)b * TOK + CTX + q0 + row) * DM + hh * 128 + part * 8) = v; }
    }
    __syncthreads();
}

__global__ void __launch_bounds__(512, 2) fwd_kernel(Args args) {
    extern __shared__ __attribute__((aligned(16))) unsigned char lds_raw[];
    LAS unsigned char* lds = (LAS unsigned char*)lds_raw;
    cg::grid_group grid = cg::this_grid();
    const int G = gridDim.x, bid = blockIdx.x;
    const int wv = __builtin_amdgcn_readfirstlane(threadIdx.x >> 6);
    const int vcu = (G % 8 == 0) ? (bid % 8) * (G / 8) + bid / 8 : bid;
    const int NGW = G * 8;
    const int lo = args.ph_lo, hi = args.ph_hi;
    int ph = 0;
    volatile LAS unsigned* bst = (volatile LAS unsigned*)(lds + LDS_BYTES - 64);
    { const int tid = wv * 64 + lane_id_v(); if (tid < 2) bst[tid] = 0u; __syncthreads(); }
    if (lo < 0) grid.sync();
    unsigned xcc;
    { KArgs kb = KA(); xcc = xcd_barrier_post((unsigned*)kb->ws, bst, wv == 0 && lane_id_v() == 0).x; }
#ifdef TPROBE
    unsigned long long tp1 = __builtin_amdgcn_s_memrealtime(), tp2 = 0; int tpn = 0;
#define TP_MARK() do { ++tpn; if (tpn == TPROBE) tp1 = __builtin_amdgcn_s_memrealtime(); if (tpn == TPROBE + 1) tp2 = __builtin_amdgcn_s_memrealtime(); } while (0)
#else
#define TP_MARK() do {} while (0)
#endif
#ifndef REP_MASK
#define REP_MASK 0
#endif
#define NREP(k) (((REP_MASK >> (k)) & 1) ? 2 : 1)
#define RUN() (lo <= ph && ph < hi)
#define XBAR() do { KArgs kb = KA(); XcdBarrier xb_; xb_.bar = (unsigned*)kb->ws; xb_.x = xcc; xb_.st = bst; xcd_barrier(xb_, wv == 0 && lane_id_v() == 0); } while (0)
#define SEAM() do { if (lo <= ph && ph + 1 < hi) { XBAR(); if ((REP_MASK >> 6) & 1) { XBAR(); } } ++ph; TP_MARK(); } while (0)

    if (RUN()) for (int rep = 0; rep < NREP(0); ++rep) {
        if (rep) XBAR();
        KArgs ka = KA();
        for (int r2 = 0; r2 < NREP(8); ++r2) ada_phase(lds, ka->in[1], ka->in[3], ka->in[5], ka->in[6], P_ADA, G, bid, wv);
        const int tid = wv * 64 + lane_id_v();
        const int lane = tid & 63, wave = wv, gw = vcu * 8 + wave;
        LAS float* scr = (LAS float*)(lds + wave * 16640);
        constexpr int I_GU = 16 * 88, I_D = 44 * 16, I_QKV = 16 * 48, I_O = 16 * 16;
        constexpr int NITEMS = 4 * I_GU + 4 * I_D + I_QKV + 2 * I_O;
        for (int r2 = 0; r2 < NREP(9); ++r2)
        for (int it = gw; it < NITEMS; it += NGW) {
            int q = it;
            if (q < 4 * I_GU) { const int f = q / I_GU; transpose_item(((f & 1) ? ka->in[9] : ka->in[7]) + (size_t)(f >> 1) * DM * NGU, DM, NGU, (bf16*)(P_WS + WS_WGU + f * WGU_SZ), true, scr, q % I_GU, lane); continue; } q -= 4 * I_GU;
            if (q < 4 * I_D) { const int f = q / I_D; transpose_item(((f & 1) ? ka->in[10] : ka->in[8]) + (size_t)(f >> 1) * DFF * DM, DFF, DM, (bf16*)(P_WS + WS_WD + f * WD_SZ), false, scr, q % I_D, lane); continue; } q -= 4 * I_D;
            if (q < I_QKV) { transpose_item(ka->in[11], DM, 3072, P_WQKV, false, scr, q, lane); continue; } q -= I_QKV;
            if (q < I_O) { transpose_item(ka->in[12], DM, DM, P_WO, false, scr, q, lane); continue; } q -= I_O;
            transpose_item(ka->in[20], DM, DM, P_WF, false, scr, q, lane);
        }
        const int gt = vcu * 512 + tid, NGT = G * 512;
        for (int r2 = 0; r2 < NREP(10); ++r2)
        for (int i = gt; i < 2048 * 256; i += NGT) { const int k = i >> 8, j0 = (i & 255) * 8; const bool isS = j0 >= 1024; const int jj = j0 & 1023;
            float v[8];
#pragma unroll
            for (int e = 0; e < 8; ++e) { const int idx = (k * (jj + e)) & 2047; float sn, cs; sincospif((float)idx * (1.0f / 1024.0f), &sn, &cs); v[e] = (isS ? -sn : cs) * 0.02209708691f; }
            u32x4 w; w.x = pk2(v[0], v[1]); w.y = pk2(v[2], v[3]); w.z = pk2(v[4], v[5]); w.w = pk2(v[6], v[7]);
            *(u32x4*)(P_DFTS + (size_t)k * 2048 + j0) = w; }
        for (int i = gt; i < 512 * 32; i += NGT) { const int f = i >> 5, c0 = (i & 31) * 8; const bool isS = f >= 256; const int ff = f & 255;
            float v[8];
#pragma unroll
            for (int e = 0; e < 8; ++e) { const int idx = (ff * (c0 + e)) & 255; float sn, cs; sincospif((float)idx * (1.0f / 128.0f), &sn, &cs); v[e] = (isS ? sn : cs) * 0.0625f; }
            u32x4 w; w.x = pk2(v[0], v[1]); w.y = pk2(v[2], v[3]); w.z = pk2(v[4], v[5]); w.w = pk2(v[6], v[7]);
            *(u32x4*)(P_DFTC + (size_t)f * 256 + c0) = w; }
        if (bid == 0 && wave == 0) {
            float p1 = wave_sum(ka->in[15][lane] * ka->in[16][lane]), p2 = wave_sum(ka->in[17][lane] * ka->in[18][lane]);
            float mq = fabsf(ka->in[13][lane]), mk = fabsf(ka->in[14][lane]);
#pragma unroll
            for (int o = 1; o < 64; o <<= 1) { mq = fmaxf(mq, __shfl_xor(mq, o)); mk = fmaxf(mk, __shfl_xor(mk, o)); }
            if (lane == 0) { P_SCAL[0] = expf(p1) - expf(p2) + 0.2f; P_SCAL[1] = 8.0f * mq * mk * 1.44269504089f; }
        }
    }
    SEAM();

    for (int fi = 0; fi < 4; ++fi) {
#define FI() int fi_ = fi; asm volatile("" : "+s"(fi_)); const int layer = fi_ >> 1, which = fi_ & 1; const bool with_ctx = (fi_ == 0); (void)layer; (void)which; (void)with_ctx
        if (RUN()) for (int rep = 0; rep < NREP(1); ++rep) { KArgs ka = KA(); FI();
            norm_phase((fi_ == 0) ? ka->in[0] : (const float*)P_OUT, ka->in[2], nullptr, ka->in[4] + (size_t)(layer * 3 + which * 2) * DM, P_ADA + (size_t)layer * 17 * NMOD, which * 6, P_HB, with_ctx, vcu, NGW, wv); }
        SEAM();
        if (RUN()) for (int rep = 0; rep < NREP(2); ++rep) {
            if (rep) XBAR();
            KArgs ka = KA(); FI();
            pg8::Gemm g{P_HB, (const bf16*)(P_WS + WS_WGU + fi_ * WGU_SZ), DM, DM, DM, 0u, 0u};
            pg8::Order S; S.init(with_ctx ? 144 : 128, 22, 1, with_ctx ? 0 : 1, 0, G, bid);
            pg8::EpiSwiglu E{P_BIG};
            pg8::gemm_phase<pg8::EpiSwiglu, pg8::Order>(lds, g, S, E, wv);
        }
        SEAM();
        if (RUN()) { KArgs ka = KA(); FI();
            pg8::Gemm g{P_BIG, (const bf16*)(P_WS + WS_WD + fi_ * WD_SZ), DFF, DFF, DFF, 0u, 0u};
            pg8::Order S; S.init(128, 4, 1, 1, 0, G, bid); if (with_ctx) S.ctxsplit = 128;
            pg8::EpiGateRes E{fi_ == 0 ? 1 : 0, layer, which * 6 + 2, 0.5f};
            pg8::gemm_phase<pg8::EpiGateRes, pg8::Order>(lds, g, S, E, wv);
        }
#ifdef TPROBE
        SEAM();
#else
        if (fi < 3) SEAM();
#endif
        if ((fi & 1) == 0) {
            if (RUN()) for (int rep = 0; rep < NREP(7); ++rep) { KArgs ka = KA(); FI();
                if (layer == 0) norm_phase(P_OUT, P_Y1, P_Y1B, ka->in[4] + (size_t)(layer * 3 + 1) * DM, P_ADA + (size_t)layer * 17 * NMOD, 3, P_HB, true, vcu, NGW, wv);
                else norm_fourier_phase(P_OUT, ka->in[4] + (size_t)(layer * 3 + 1) * DM, P_ADA + (size_t)layer * 17 * NMOD, P_HB, (float*)(P_WS + WS_H1024), vcu, NGW, wv); }
            SEAM();
            if (fi == 0) {
                if (RUN()) for (int rep = 0; rep < NREP(5); ++rep) {
                    if (rep) XBAR();
                    { KArgs ka = KA();
                        pg8::Gemm g{P_HB, P_WQKV, DM, DM, DM, 0, 0}; pg8::Order S; S.init(128, 4, 1, 1, 0, G, bid); pg8::EpiQKV E{1};
                        pg8::gemm_phase<pg8::EpiQKV, pg8::Order>(lds, g, S, E, wv); }
                    { KArgs ka = KA();
                        const bf16* WK = P_WQKV + (size_t)1024 * DM; const bf16* WV = P_WQKV + (size_t)2048 * DM;
                        pg8::Gemm g{P_HB, WK, DM, DM, DM, (long long)((const char*)WV - (const char*)P_HB), (long long)((const char*)P_HB - (const char*)WK)};
                        pg8::Order S; S.init(144, 4, 2, 0, 0, G, bid); S.swapg = 1; pg8::EpiQKV E{2};
                        pg8::gemm_phase<pg8::EpiQKV, pg8::Order>(lds, g, S, E, wv); }
                }
                SEAM();
                if (RUN()) for (int rep = 0; rep < NREP(3); ++rep) { KArgs ka = KA();
                    attn_phase(lds, P_BIG, P_BIG + QK_STRIDE, P_BIG + 2 * QK_STRIDE, P_HB, 0.8f, G, bid, wv); }
                SEAM();
            } else {
                if (RUN()) for (int rep = 0; rep < NREP(4); ++rep) {
                    if (rep) XBAR();
                    KArgs ka = KA();
                    pg8::Gemm g{P_DFTC, P_HB, 256, 256, DM, 0u, 512u};
                    pg8::Order S; S.init(1, 128, 4, 0, 1, G, bid); S.chan = 1;
                    pg8::EpiChan E{P_BIG};
                    pg8::gemm_phase<pg8::EpiChan, pg8::Order>(lds, g, S, E, wv);
                    {   KArgs ka = KA();
                        const int tid = wv * 64 + lane_id_v();
                        for (int i8 = vcu * 512 + tid; i8 < NB * 1024 * 8; i8 += G * 512) { const int i = i8 >> 3, part = i8 & 7, b = i >> 10, chn = i & 1023, gq = chn >> 8, m = chn & 255;
                            const f32x4* hp = (const f32x4*)((const float*)(P_WS + WS_H1024) + (size_t)b * DM + gq * 256) + 8 * part; const u32x2* cp = (const u32x2*)(P_DFTC + (size_t)m * 256) + 8 * part;
                            f32x4 hv[8]; u32x2 cw[8];
#pragma unroll
                            for (int c4 = 0; c4 < 8; ++c4) { hv[c4] = hp[c4]; cw[c4] = cp[c4]; }
                            float sum = 0.f;
#pragma unroll
                            for (int c4 = 0; c4 < 8; ++c4) sum += hv[c4].x * bf_lo(cw[c4].x) + hv[c4].y * bf_hi(cw[c4].x) + hv[c4].z * bf_lo(cw[c4].y) + hv[c4].w * bf_hi(cw[c4].y);
                            sum += shx<1>(sum); sum += shx<2>(sum); sum += shx<4>(sum);
                            if (part == 0) ((float*)(P_WS + WS_T))[i] = sum * 0.02209708691f; }
                    }
                }
                SEAM();
                if (RUN()) for (int rep = 0; rep < NREP(4); ++rep) {
                    if (rep) XBAR();
                    KArgs ka = KA();
                    pg8::Gemm g{P_DFTS, P_BIG, 2048, 2048, 2048, 0u, 0u};
                    pg8::Order S; S.init(8, 64, 1, 0, 0, G, bid);
                    pg8::EpiSeq E{P_HB + (size_t)CTX * DM, (const float*)(P_WS + WS_T)};
                    pg8::gemm_phase<pg8::EpiSeq, pg8::Order>(lds, g, S, E, wv);
                }
                SEAM();
            }
            if (RUN()) { KArgs ka = KA(); FI();
                pg8::Gemm g{P_HB, layer == 0 ? P_WO : P_WF, DM, DM, DM, 0u, 0u};
                pg8::Order S; S.init(128, 4, 1, 1, 0, G, bid);
                pg8::EpiGateRes E{0, layer, 5, 1.0f};
                pg8::gemm_phase<pg8::EpiGateRes, pg8::Order>(lds, g, S, E, wv);
            }
            SEAM();
        }
    }
#ifdef TPROBE
    XBAR();
    if (bid == 0 && wv == 0 && lane_id_v() == 0) { KArgs ka = KA(); const float us = (float)(tp2 - tp1) * 0.01f; P_OUT[0] += us * (1.0f / TPSCALE); }
#endif
#undef RUN
#undef SEAM
}

extern "C" void kernel_launch(void* const* d_in, const int* in_sizes, int n_in, void* d_out, int out_size, void* d_ws, size_t ws_size, hipStream_t stream) {
    static int grid = 0;
    if (grid == 0) {
        if (n_in != 21 || ws_size < WS_END) { fprintf(stderr, "kernel_launch: unexpected n_in %d / ws %zu\n", n_in, ws_size); grid = -1; return; }
        int dev = 0, cus = 0, per_cu = 0;
        hipGetDevice(&dev); hipDeviceGetAttribute(&cus, hipDeviceAttributeMultiprocessorCount, dev);
        if (hipFuncSetAttribute((const void*)fwd_kernel, hipFuncAttributeMaxDynamicSharedMemorySize, LDS_BYTES) != hipSuccess) { fprintf(stderr, "kernel_launch: hipFuncSetAttribute failed\n"); grid = -1; return; }
        if (hipOccupancyMaxActiveBlocksPerMultiprocessor(&per_cu, (const void*)fwd_kernel, 512, LDS_BYTES) != hipSuccess || per_cu < 1) { fprintf(stderr, "kernel_launch: occupancy query gave %d\n", per_cu); per_cu = 1; }
        (void)hipGetLastError();
        grid = cus * per_cu;
    }
    if (grid < 0) return;
    if (hipMemsetAsync(d_ws, 0, 16384, stream) != hipSuccess) { fprintf(stderr, "kernel_launch: hipMemsetAsync failed\n"); return; }
    Args a{};
    for (int i = 0; i < 21; ++i) a.in[i] = (const float*)d_in[i];
    a.out = (float*)d_out; a.ws = (unsigned char*)d_ws; a.ph_lo = 0; a.ph_hi = 1000;
    void* kargs[] = {&a};
    hipError_t e = hipLaunchCooperativeKernel((const void*)fwd_kernel, dim3(grid), dim3(512), kargs, LDS_BYTES, stream);
    if (e != hipSuccess) fprintf(stderr, "cooperative launch failed: %s (grid %d)\n", hipGetErrorString(e), grid);
}
```

```cpp
#include <hip/hip_runtime.h>
#include <hip/hip_cooperative_groups.h>
#include <cstdio>
#include <cstdint>
namespace cg = cooperative_groups;

#define LAS __attribute__((address_space(3)))
typedef unsigned short bf16;
typedef short bf16x8 __attribute__((ext_vector_type(8)));
typedef float f32x4 __attribute__((ext_vector_type(4)));
typedef float f32x2 __attribute__((ext_vector_type(2)));
typedef float f32x16 __attribute__((ext_vector_type(16)));
typedef unsigned u32x4 __attribute__((ext_vector_type(4)));
typedef unsigned u32x2 __attribute__((ext_vector_type(2)));
typedef __bf16 bf16x2_t __attribute__((ext_vector_type(2)));

__device__ __forceinline__ unsigned pk2(float lo, float hi) { f32x2 v = {lo, hi}; bf16x2_t b = __builtin_convertvector(v, bf16x2_t); return __builtin_bit_cast(unsigned, b); }
__device__ __forceinline__ float bf_lo(unsigned w) { return __uint_as_float(w << 16); }
__device__ __forceinline__ float bf_hi(unsigned w) { return __uint_as_float(w & 0xffff0000u); }
__device__ __forceinline__ int lane_id_v() { int l; asm volatile("v_mbcnt_lo_u32_b32 %0, -1, 0\n\tv_mbcnt_hi_u32_b32 %0, -1, %0" : "=v"(l)); return l; }
template <int M> __device__ __forceinline__ float shx(float v) { return __builtin_bit_cast(float, __builtin_amdgcn_ds_swizzle(__builtin_bit_cast(int, v), (M << 10) | 0x1f)); }
__device__ __forceinline__ float add_x32(float v) { const unsigned u = __builtin_bit_cast(unsigned, v); auto rr = __builtin_amdgcn_permlane32_swap(u, u, false, false); return __uint_as_float(rr[0]) + __uint_as_float(rr[1]); }
__device__ __forceinline__ float wave_sum(float v) { v += shx<1>(v); v += shx<2>(v); v += shx<4>(v); v += shx<8>(v); v += shx<16>(v); return add_x32(v); }

constexpr int DM = 1024, NB = 16, SEQ = 2048, CTX = 256, TOK = 2304, MC = NB * TOK  , MX = NB * SEQ  , DFF = 2816, NGU = 5632, NMOD = 9216;
constexpr float EPS = 1e-6f;
constexpr float QSCALE = 0.125f * 1.44269504089f;
constexpr size_t MiB = 1u << 20;
constexpr size_t WS_ADA = 1 * MiB;
constexpr size_t WS_SCAL = 3 * MiB;
constexpr size_t WS_ROPE = 3 * MiB + 4096;
constexpr size_t WS_H1024 = 3 * MiB + 640 * 1024;
constexpr size_t WS_T = 3 * MiB + 768 * 1024;
constexpr size_t WS_WGU = 4 * MiB;
constexpr size_t WS_WD = 48 * MiB;
constexpr size_t WS_WQKV = 70 * MiB;
constexpr size_t WS_WO = 76 * MiB;
constexpr size_t WS_WF = 78 * MiB;
constexpr size_t WS_DFTS = 80 * MiB;
constexpr size_t WS_DFTC = 96 * MiB;
constexpr size_t WS_Y1 = 98 * MiB;
constexpr size_t WS_HB = 114 * MiB;
constexpr size_t WS_BIG = 186 * MiB;
constexpr size_t WS_Y1B = 402 * MiB;
constexpr size_t WS_END = 418 * MiB;
constexpr size_t WGU_SZ = (size_t)NGU * DM * 2, WD_SZ = (size_t)DM * DFF * 2;
constexpr size_t QK_STRIDE = (size_t)MC * DM;
constexpr int LDS_BYTES = 147456;

struct Args { const float* in[21]; float* out; unsigned char* ws; int ph_lo, ph_hi; };
typedef const __attribute__((address_space(4))) Args* KArgs;
#define KA() ({ KArgs _p = (KArgs)__builtin_amdgcn_kernarg_segment_ptr(); asm volatile("" : "+s"(_p)); _p; })
#define P_WS   (ka->ws)
#define P_OUT  (ka->out)
#define P_ADA  ((float*)(ka->ws + WS_ADA))
#define P_SCAL ((float*)(ka->ws + WS_SCAL))
#define P_ROPE ((f32x2*)(ka->ws + WS_ROPE))
#define P_WQKV ((bf16*)(ka->ws + WS_WQKV))
#define P_WO   ((bf16*)(ka->ws + WS_WO))
#define P_WF   ((bf16*)(ka->ws + WS_WF))
#define P_DFTS ((bf16*)(ka->ws + WS_DFTS))
#define P_DFTC ((bf16*)(ka->ws + WS_DFTC))
#define P_Y1   ((float*)(ka->ws + WS_Y1))
#define P_Y1B  ((float*)(ka->ws + WS_Y1B))
#define P_HB   ((bf16*)(ka->ws + WS_HB))
#define P_BIG  ((bf16*)(ka->ws + WS_BIG))

namespace pg8 {
#define PG8_LAS __attribute__((address_space(3)))
typedef unsigned short bf16_t;
constexpr int BM = 256, BK = 64, HALF = 128, HTB = HALF * BK * 2, STAGE_BYTES = 8 * HTB, NXCD = 8, WGM = 8;

__host__ __device__ __forceinline__ int lds_byte(int r, int c) { const int st = (r >> 4) * 2 + (c >> 5), rr = r & 15, cc = c & 31, ob = rr * 64 + cc * 2; return st * 1024 + (ob ^ (((ob >> 9) & 1) << 5)); }
__host__ __device__ __forceinline__ void stage_rc(int b, int& R, int& C) { const int st = b / 1024, sb = b % 1024, swz = sb ^ (((sb >> 9) & 1) << 5); R = (st >> 1) * 16 + swz / 64; C = (st & 1) * 32 + (swz % 64) / 2; }
__host__ __device__ __forceinline__ int perm32(int rho) { const int n = rho >> 4, i = rho & 15; return 8 * (i >> 2) + 4 * n + (i & 3); }

struct Unit { int pm, pn, g, kt0, ktn; };
struct Gemm { const bf16_t* A; const bf16_t* Bt; int K, lda, ldb; long long gstepA, gstepB; };

struct Order {
    int nM, nN, per, total, G, c, remapM, remapN, chan, swapg, ctxsplit;
    __device__ __forceinline__ void init(int nM_, int nN_, int nG_, int remapM_, int remapN_, int G_, int c_) { asm volatile("" : "+s"(c_), "+s"(G_));
        nM = nM_; nN = nN_; per = nM_ * nN_; total = per * nG_; remapM = remapM_; remapN = remapN_; G = G_; c = c_; chan = 0; swapg = 0; ctxsplit = 0; }
    __device__ __forceinline__ bool next(int i, Unit& u) const {
        const long L = (long)i * G + c; if (L >= total + ctxsplit) return false;
        u.kt0 = 0; u.ktn = 0;
        if (L >= total) {
            const int idx = (int)L - total, t = idx >> 1; u.g = idx & 1; u.pm = (t >> 2) * 9; u.pn = t & 3; u.kt0 = u.g * 22; u.ktn = 22; return true; }
        int wgid = (int)L; { const int q = total / NXCD, r = total % NXCD, xcd = wgid % NXCD, off = wgid / NXCD; wgid = (xcd < r ? xcd * (q + 1) : r * (q + 1) + (xcd - r) * q) + off; }
        u.g = wgid / per; const int w = wgid % per;
        const bool sw = swapg && u.g; const int nM = sw ? this->nN : this->nM, nN = sw ? this->nM : this->nN;
        const int nig = WGM * nN, gid = w / nig, fm = gid * WGM, gsz = (nM - fm) < WGM ? (nM - fm) : WGM;
        int pm = fm + ((w % nig) % gsz), pn = (w % nig) / gsz;
        if (remapM) pm = (pm >> 3) * 9 + 1 + (pm & 7);
        if (remapN) pn = (pn >> 3) * 9 + 1 + (pn & 7);
        if (chan) pm = ((pn % 9) - 1) >> 2;
        u.pm = pm; u.pn = pn; return true;
    }
    __device__ __forceinline__ void a_ready(const Unit&) const {}
    __device__ __forceinline__ void done(const Unit&) const {}
};

struct EpiBf16Split {
    static constexpr bool PERM = true, AFTER_DRAIN = false;
    bf16_t* O; int ldc; int split_cols; size_t split_stride;
    __device__ __forceinline__ void operator()(const f32x4 (&acc)[2][2][4][2], const Unit& u, int wr, int wc, int fr, int fq) const {
        const int row0 = u.pm * BM + wr * 64 + fr; int colt = u.pn * BM; bf16_t* base = O;
        { const int t = colt / split_cols; base += (size_t)t * split_stride; colt -= t * split_cols; }
        const int col0 = colt + wc * 32 + 8 * fq;
#pragma unroll
        for (int ai = 0; ai < 2; ++ai)
#pragma unroll
            for (int m = 0; m < 4; ++m) { bf16_t* rowp = base + (size_t)(row0 + ai * HALF + m * 16) * ldc + col0;
#pragma unroll
                for (int bj = 0; bj < 2; ++bj) { const f32x4 v0 = acc[ai][bj][m][0], v1 = acc[ai][bj][m][1];
                    u32x4 w; w.x = pk2(v0[0], v0[1]); w.y = pk2(v0[2], v0[3]); w.z = pk2(v1[0], v1[1]); w.w = pk2(v1[2], v1[3]);
                    *(u32x4*)(rowp + bj * HALF) = w; } }
    }
};
struct EpiQKV {
    static constexpr bool PERM = true, AFTER_DRAIN = false;
    int call;
    __device__ __forceinline__ void operator()(const f32x4 (&acc)[2][2][4][2], const Unit& u, int wr, int wc, int fr, int fq) const {
        asm volatile("" : "+v"(fr), "+v"(fq));
        KArgs ka = KA();
        if (call == 2 && u.g == 1) {
            const int row0 = u.pm * BM + wr * 64 + fr; int colt = u.pn * BM; const int t = colt / TOK; colt -= t * TOK;
            bf16_t* base = P_BIG + 2 * QK_STRIDE + (size_t)t * 1024 * TOK; const int col0 = colt + wc * 32 + 8 * fq;
#pragma unroll
            for (int ai = 0; ai < 2; ++ai)
#pragma unroll
                for (int m = 0; m < 4; ++m) { bf16_t* rowp = base + (size_t)(row0 + ai * HALF + m * 16) * TOK + col0;
#pragma unroll
                    for (int bj = 0; bj < 2; ++bj) { const f32x4 v0 = acc[ai][bj][m][0], v1 = acc[ai][bj][m][1];
                        u32x4 w; w.x = pk2(v0[0], v0[1]); w.y = pk2(v0[2], v0[3]); w.z = pk2(v1[0], v1[1]); w.w = pk2(v1[2], v1[3]);
                        *(u32x4*)(rowp + bj * HALF) = w; } }
            return;
        }
        const bool isK = (call == 2);
        const int jt = u.pm % 9;
        bf16_t* base = P_BIG + (isK ? QK_STRIDE : 0) + (size_t)(u.pm * BM) * DM + (u.pn * 4 + wc) * 64;
        const float* gn = isK ? ka->in[14] : ka->in[13];
        float cf[2][4];
#pragma unroll
        for (int n = 0; n < 2; ++n)
#pragma unroll
            for (int e = 0; e < 4; ++e) cf[n][e] = __builtin_amdgcn_exp2f(-(float)(8 * (fq & 1) + 4 * n + e) * 0.830482023722f) * 0.159154943092f;
        f32x4 gv[2][2];
#pragma unroll
        for (int bj = 0; bj < 2; ++bj)
#pragma unroll
            for (int n = 0; n < 2; ++n) gv[bj][n] = *(const f32x4*)(gn + bj * 32 + 8 * fq + 4 * n);
        const bool hi = fq >= 2;
#pragma unroll
        for (int ai = 0; ai < 2; ++ai)
#pragma unroll
            for (int m = 0; m < 4; ++m) {
                const int rl = ai * HALF + wr * 64 + m * 16 + fr;
                float ss = 0.f;
#pragma unroll
                for (int bj = 0; bj < 2; ++bj)
#pragma unroll
                    for (int n = 0; n < 2; ++n) { const f32x4 a = acc[ai][bj][m][n]; ss += (a.x * a.x + a.y * a.y) + (a.z * a.z + a.w * a.w); }
                ss += shx<16>(ss); ss = add_x32(ss);
                const float rstd = rsqrtf(ss * (1.f / 64.f) + EPS);
                f32x4 v[2][2];
#pragma unroll
                for (int bj = 0; bj < 2; ++bj)
#pragma unroll
                    for (int n = 0; n < 2; ++n) v[bj][n] = acc[ai][bj][m][n] * rstd * gv[bj][n];
                if (jt > 0) {
                    const int pos = (jt - 1) * 256 + rl;
#pragma unroll
                    for (int bj = 0; bj < 2; ++bj) { const float apos = (float)(bj ? (pos & 63) : (pos >> 6));
#pragma unroll
                        for (int n = 0; n < 2; ++n) {
                            f32x4 pv, cs, sn;
#pragma unroll
                            for (int e = 0; e < 4; ++e) { const float xr = __builtin_amdgcn_fractf(apos * cf[n][e]); sn[e] = __builtin_amdgcn_sinf(xr); cs[e] = __builtin_amdgcn_cosf(xr); }
#pragma unroll
                            for (int e = 0; e < 4; ++e) { float pa = v[bj][n][e], pb = pa;
                                asm volatile("s_nop 1\n\tv_permlane32_swap_b32 %0, %1" : "+v"(pa), "+v"(pb)); pv[e] = hi ? pa : pb; }
                            v[bj][n] = hi ? (v[bj][n] * cs + pv * sn) : (v[bj][n] * cs - pv * sn); } }
                }
                if (!isK) {
#pragma unroll
                    for (int bj = 0; bj < 2; ++bj)
#pragma unroll
                        for (int n = 0; n < 2; ++n) v[bj][n] = v[bj][n] * QSCALE;
                }
                bf16_t* rowp = base + (size_t)rl * DM + 8 * fq;
#pragma unroll
                for (int bj = 0; bj < 2; ++bj) { u32x4 w; w.x = pk2(v[bj][0][0], v[bj][0][1]); w.y = pk2(v[bj][0][2], v[bj][0][3]); w.z = pk2(v[bj][1][0], v[bj][1][1]); w.w = pk2(v[bj][1][2], v[bj][1][3]);
                    *(u32x4*)(rowp + bj * 32) = w; }
            }
    }
};
struct EpiSwiglu {
    static constexpr bool PERM = true, AFTER_DRAIN = false;
    bf16_t* O;
    __device__ __forceinline__ void operator()(const f32x4 (&acc)[2][2][4][2], const Unit& u, int wr, int wc, int fr, int fq) const {
        const int row0 = u.pm * BM + wr * 64 + fr, col0 = u.pn * HALF + wc * 32 + 8 * fq;
#pragma unroll
        for (int ai = 0; ai < 2; ++ai)
#pragma unroll
            for (int m = 0; m < 4; ++m) { bf16_t* rowp = O + (size_t)(row0 + ai * HALF + m * 16) * 2816 + col0;
                float v[8];
#pragma unroll
                for (int n = 0; n < 2; ++n)
#pragma unroll
                    for (int j = 0; j < 4; ++j) { const float g = acc[ai][0][m][n][j], uu = acc[ai][1][m][n][j];
                        v[4 * n + j] = g * uu * __builtin_amdgcn_rcpf(1.0f + __builtin_amdgcn_exp2f(-g)); }
                u32x4 w; w.x = pk2(v[0], v[1]); w.y = pk2(v[2], v[3]); w.z = pk2(v[4], v[5]); w.w = pk2(v[6], v[7]);
                *(u32x4*)rowp = w; }
    }
};
struct EpiGateRes {
    static constexpr bool PERM = false, AFTER_DRAIN = false;
    int first; int layer; int kg; float coef;
    __device__ __forceinline__ void operator()(const f32x4 (&acc)[2][2][4][2], const Unit& u, int wr, int wc, int fr, int fq) const {
        KArgs ka = KA();
        const int b = u.pm / 9, j = u.pm % 9; const float* rb; float* ob; int s;
        const bool nores = u.ktn && u.g;
        if (j == 0) { const size_t off = (size_t)b * 256 * 1024; rb = ka->in[2] + off; ob = (nores ? P_Y1B : P_Y1) + off; s = 16; }
        else { const size_t off = ((size_t)b * 2048 + (size_t)(j - 1) * 256) * 1024; rb = (first ? ka->in[0] : (const float*)P_OUT) + off; ob = P_OUT + off; s = b; }
        const float* gate = P_ADA + (size_t)layer * 17 * NMOD + (size_t)(s * 9 + kg) * 1024;
        const int row0 = wr * 64 + fr, col0 = u.pn * BM + wc * 32 + 4 * fq;
        f32x4 gv[2][2];
#pragma unroll
        for (int bj = 0; bj < 2; ++bj)
#pragma unroll
            for (int n = 0; n < 2; ++n) gv[bj][n] = *(const f32x4*)(gate + col0 + bj * HALF + n * 16) * coef;
        constexpr int NB_ = 4;
#pragma unroll
        for (int ai = 0; ai < 2; ++ai)
#pragma unroll
            for (int m0 = 0; m0 < 4; m0 += NB_) {
                f32x4 r[NB_][2][2];
#pragma unroll
                for (int mm = 0; mm < NB_; ++mm) { const size_t roff = (size_t)(row0 + ai * HALF + (m0 + mm) * 16) * 1024 + col0;
#pragma unroll
                    for (int bj = 0; bj < 2; ++bj)
#pragma unroll
                        for (int n = 0; n < 2; ++n) { r[mm][bj][n] = (f32x4){0.f, 0.f, 0.f, 0.f}; if (!nores) r[mm][bj][n] = *(const f32x4*)(rb + roff + bj * HALF + n * 16); } }
#pragma unroll
                for (int mm = 0; mm < NB_; ++mm) { const size_t roff = (size_t)(row0 + ai * HALF + (m0 + mm) * 16) * 1024 + col0;
#pragma unroll
                    for (int bj = 0; bj < 2; ++bj)
#pragma unroll
                        for (int n = 0; n < 2; ++n) *(f32x4*)(ob + roff + bj * HALF + n * 16) = r[mm][bj][n] + gv[bj][n] * acc[ai][bj][m0 + mm][n]; } }
    }
};
struct EpiChan {
    static constexpr bool PERM = true, AFTER_DRAIN = false;
    bf16_t* XT;
    __device__ __forceinline__ void operator()(const f32x4 (&acc)[2][2][4][2], const Unit& u, int wr, int wc, int fr, int fq) const {
        const int b = u.pn / 9, jt = u.pn % 9 - 1;
        bf16_t* base = XT + (size_t)(b * 1024 + u.g * 256) * 2048 + jt * 256;
        const int row0 = wr * 64 + fr, col0 = wc * 32 + 8 * fq;
#pragma unroll
        for (int ai = 0; ai < 2; ++ai)
#pragma unroll
            for (int m = 0; m < 4; ++m) { bf16_t* rowp = base + (size_t)(row0 + ai * HALF + m * 16) * 2048 + col0;
#pragma unroll
                for (int bj = 0; bj < 2; ++bj) { const f32x4 v0 = acc[ai][bj][m][0], v1 = acc[ai][bj][m][1];
                    u32x4 w; w.x = pk2(v0[0], v0[1]); w.y = pk2(v0[2], v0[3]); w.z = pk2(v1[0], v1[1]); w.w = pk2(v1[2], v1[3]);
                    *(u32x4*)(rowp + bj * HALF) = w; } }
    }
};
struct EpiSeq {
    static constexpr bool PERM = true, AFTER_DRAIN = false;
    bf16_t* O; const float* T;
    __device__ __forceinline__ void operator()(const f32x4 (&acc)[2][2][4][2], const Unit& u, int wr, int wc, int fr, int fq) const {
        const int row0 = u.pm * BM + wr * 64 + fr; const int colt = u.pn * BM; const int b = colt >> 10;
        bf16_t* base = O + (size_t)b * 2304 * 1024;
        const int col0 = (colt & 1023) + wc * 32 + 8 * fq;
        const float sg = (fr & 1) ? -1.0f : 1.0f;
        f32x4 tv[2][2];
#pragma unroll
        for (int bj = 0; bj < 2; ++bj)
#pragma unroll
            for (int n = 0; n < 2; ++n) tv[bj][n] = *(const f32x4*)(T + colt + wc * 32 + 8 * fq + bj * HALF + 4 * n) * sg;
#pragma unroll
        for (int ai = 0; ai < 2; ++ai)
#pragma unroll
            for (int m = 0; m < 4; ++m) { bf16_t* rowp = base + (size_t)(row0 + ai * HALF + m * 16) * 1024 + col0;
#pragma unroll
                for (int bj = 0; bj < 2; ++bj) { const f32x4 v0 = acc[ai][bj][m][0] + tv[bj][0], v1 = acc[ai][bj][m][1] + tv[bj][1];
                    u32x4 w; w.x = pk2(v0[0], v0[1]); w.y = pk2(v0[2], v0[3]); w.z = pk2(v1[0], v1[1]); w.w = pk2(v1[2], v1[3]);
                    *(u32x4*)(rowp + bj * HALF) = w; } }
    }
};

template <class Epi, class Sched, bool ALIGN_EPI = true>
__device__ __forceinline__ void gemm_phase(PG8_LAS unsigned char* lds, const Gemm g, const Sched& S, const Epi& E, int wv) {
    const int tid = wv * 64 + lane_id_v();
    const int wid = __builtin_amdgcn_readfirstlane(tid >> 6), lane = tid & 63, wr = wid >> 2, wc = wid & 3, fr = lane & 15, fq = lane >> 4;
    int K = g.K, lda = g.lda, ldb = g.ldb; asm volatile("" : "+s"(K), "+s"(lda), "+s"(ldb));
    const int ntK = K / BK;
    unsigned voffA[2], voffB[2];
#pragma unroll
    for (int i = 0; i < 2; ++i) { int R, C; stage_rc(tid * 16 + i * 8192, R, C); const int Rb = Epi::PERM ? ((R & ~31) + perm32(R & 31)) : R;
        voffA[i] = (unsigned)(R * lda + C) * 2u; voffB[i] = (unsigned)(Rb * ldb + C) * 2u; }
    const size_t kstep = (size_t)(BK * 2);
    const size_t hstepA = (size_t)HALF * lda * 2, hstepB = (size_t)HALF * ldb * 2;
    const size_t tstepA = 2 * hstepA, tstepB = 2 * hstepB;
    const unsigned ldsw = (unsigned)wid * 1024u;
    const int aoff = lds_byte(wr * 64 + fr, fq * 8), boff = lds_byte(wc * 32 + fr, fq * 8);
#define PG8_SA(b, h) (((b) * 2 + (h)) * HTB)
#define PG8_SB(b, h) ((4 + (b) * 2 + (h)) * HTB)
#define PG8_STAGE(bufoff, gbase, voff) do { _Pragma("unroll") for (int _i = 0; _i < 2; ++_i) \
        __builtin_amdgcn_global_load_lds((const unsigned*)((const char*)(gbase) + (voff)[_i]), (PG8_LAS unsigned*)(lds + (bufoff) + ldsw + _i * 8192), 16, 0, 0); } while (0)
#define PG8_LDA(dst, b, h) do { _Pragma("unroll") for (int m = 0; m < 4; ++m) _Pragma("unroll") for (int k = 0; k < 2; ++k) dst[m][k] = *(const PG8_LAS bf16x8*)(lds + PG8_SA(b, h) + aoff + m * 2048 + k * 1024); } while (0)
#define PG8_LDB(dst, b, h) do { _Pragma("unroll") for (int n = 0; n < 2; ++n) _Pragma("unroll") for (int k = 0; k < 2; ++k) dst[n][k] = *(const PG8_LAS bf16x8*)(lds + PG8_SB(b, h) + boff + n * 2048 + k * 1024); } while (0)
#define PG8_MMA(ai, bj, At, Bt) do { __builtin_amdgcn_s_setprio(1); _Pragma("unroll") for (int m = 0; m < 4; ++m) _Pragma("unroll") for (int n = 0; n < 2; ++n) _Pragma("unroll") for (int k = 0; k < 2; ++k) \
        acc[ai][bj][m][n] = __builtin_amdgcn_mfma_f32_16x16x32_bf16(Bt[n][k], At[m][k], acc[ai][bj][m][n], 0, 0, 0); __builtin_amdgcn_s_setprio(0); } while (0)
#define PG8_WAIT_V(n) asm volatile("s_waitcnt vmcnt(" #n ")" ::: "memory")
#define PG8_WAIT_L(n) asm volatile("s_waitcnt lgkmcnt(" #n ")" ::: "memory")
#define PG8_BAR __builtin_amdgcn_s_barrier()
#define PG8_SCHED __builtin_amdgcn_sched_barrier(0)
    Unit cur, nxt; int ui = 0;
    if (!S.next(0, cur)) return;
    f32x4 acc[2][2][4][2];
#pragma unroll
    for (int a = 0; a < 2; ++a)
#pragma unroll
        for (int b = 0; b < 2; ++b)
#pragma unroll
            for (int m = 0; m < 4; ++m)
#pragma unroll
                for (int n = 0; n < 2; ++n) acc[a][b][m][n] = (f32x4){0.f, 0.f, 0.f, 0.f};
    bf16x8 At[4][2], B0[2][2], B1[2][2];
    const char* cA = (const char*)g.A + (size_t)cur.pm * tstepA + (long long)cur.g * g.gstepA + (size_t)cur.kt0 * (BK * 2); const char* cB = (const char*)g.Bt + (size_t)cur.pn * tstepB + (long long)cur.g * g.gstepB + (size_t)cur.kt0 * (BK * 2);
    S.a_ready(cur);
    PG8_STAGE(PG8_SB(0, 0), cB, voffB); PG8_STAGE(PG8_SB(0, 1), cB + hstepB, voffB); PG8_STAGE(PG8_SA(0, 0), cA, voffA); PG8_STAGE(PG8_SA(0, 1), cA + hstepA, voffA);
    if (wr == 1) PG8_BAR;
    PG8_WAIT_V(2); PG8_BAR;
    PG8_STAGE(PG8_SB(1, 0), cB + kstep, voffB); PG8_STAGE(PG8_SA(1, 0), cA + kstep, voffA); PG8_STAGE(PG8_SB(1, 1), cB + hstepB + kstep, voffB);
    PG8_WAIT_V(6); PG8_BAR;
    for (;;) {
        const bool has_next = S.next(ui + 1, nxt);
        const char* nA = has_next ? (const char*)g.A + (size_t)nxt.pm * tstepA + (long long)nxt.g * g.gstepA + (size_t)nxt.kt0 * (BK * 2) : cA; const char* nB = has_next ? (const char*)g.Bt + (size_t)nxt.pn * tstepB + (long long)nxt.g * g.gstepB + (size_t)nxt.kt0 * (BK * 2) : cB;
        const int nt = cur.ktn ? cur.ktn : ntK;
        for (int t = 0; t < nt; t += 2) {
            const bool last = (t == nt - 2);
            const char* a1 = cA + (size_t)(t + 1) * kstep;
            const char* a2 = last ? nA : cA + (size_t)(t + 2) * kstep; const char* b2 = last ? nB : cB + (size_t)(t + 2) * kstep;
            const char* a3 = a2 + kstep; const char* b3 = b2 + kstep;
            if (last && has_next) S.a_ready(nxt);
            PG8_LDB(B0, 0, 0); PG8_LDB(B1, 0, 1); PG8_SCHED; PG8_LDA(At, 0, 0); PG8_STAGE(PG8_SA(1, 1), a1 + hstepA, voffA);
            PG8_WAIT_V(8); PG8_WAIT_L(0); PG8_BAR; PG8_MMA(0, 0, At, B0); PG8_MMA(0, 1, At, B1); PG8_BAR; PG8_SCHED;
            PG8_LDA(At, 0, 1); PG8_STAGE(PG8_SB(0, 0), b2, voffB); PG8_STAGE(PG8_SB(0, 1), b2 + hstepB, voffB); PG8_STAGE(PG8_SA(0, 0), a2, voffA);
            PG8_WAIT_V(8); PG8_WAIT_L(0); PG8_BAR; PG8_MMA(1, 0, At, B0); PG8_MMA(1, 1, At, B1); PG8_BAR; PG8_SCHED;
            PG8_LDB(B0, 1, 0); PG8_LDB(B1, 1, 1); PG8_SCHED; PG8_LDA(At, 1, 0); PG8_STAGE(PG8_SA(0, 1), a2 + hstepA, voffA);
            PG8_WAIT_V(8); PG8_WAIT_L(0); PG8_BAR; PG8_MMA(0, 0, At, B0); PG8_MMA(0, 1, At, B1); PG8_BAR; PG8_SCHED;
            PG8_LDA(At, 1, 1); PG8_STAGE(PG8_SB(1, 0), b3, voffB); PG8_STAGE(PG8_SB(1, 1), b3 + hstepB, voffB); PG8_STAGE(PG8_SA(1, 0), a3, voffA);
            PG8_WAIT_V(8); PG8_WAIT_L(0); PG8_BAR; PG8_MMA(1, 0, At, B0); PG8_MMA(1, 1, At, B1); PG8_BAR; PG8_SCHED;
        }
        if constexpr (ALIGN_EPI) { if (wr == 0) PG8_BAR; }
        E(acc, cur, wr, wc, fr, fq); S.done(cur);
        if (!has_next) break;
#pragma unroll
        for (int a = 0; a < 2; ++a)
#pragma unroll
            for (int b = 0; b < 2; ++b)
#pragma unroll
                for (int m = 0; m < 4; ++m)
#pragma unroll
                    for (int n = 0; n < 2; ++n) acc[a][b][m][n] = (f32x4){0.f, 0.f, 0.f, 0.f};
        cur = nxt; cA = nA; cB = nB; ++ui;
        if constexpr (ALIGN_EPI) { if (wr == 1) PG8_BAR; }
    }
    PG8_WAIT_V(0);
    if constexpr (!ALIGN_EPI) { if (wr == 0) PG8_BAR; }
    PG8_BAR;
#undef PG8_SA
#undef PG8_SB
#undef PG8_STAGE
#undef PG8_LDA
#undef PG8_LDB
#undef PG8_MMA
#undef PG8_WAIT_V
#undef PG8_WAIT_L
#undef PG8_BAR
#undef PG8_SCHED
}
}


#define XB_TMO      128
#define XB_XCNT(j)  (256  + 64 * (j))
#define XB_XSUB(j)  (1280 + 64 * (j))
#define XB_XGEN(j)  (2304 + 64 * (j))
#define XB_TOP      3328
#define XB_TOPGEN   3392
#define XCD_BAR_WORDS 3456
#define XB_SPIN_CAP (1u << 18)
__device__ __forceinline__ unsigned xb_ld(unsigned* p)              { return __hip_atomic_load(p, __ATOMIC_RELAXED, __HIP_MEMORY_SCOPE_AGENT); }
__device__ __forceinline__ unsigned xb_add(unsigned* p, unsigned v) { return __hip_atomic_fetch_add(p, v, __ATOMIC_RELAXED, __HIP_MEMORY_SCOPE_AGENT); }
__device__ __forceinline__ unsigned xb_xcc_id() { return (unsigned)__builtin_amdgcn_s_getreg((3 << 11) | 20) & 0xFu; }
#define XB_SPIN(cond, bar) do { unsigned _sp = 0; while (cond) { __builtin_amdgcn_s_sleep(1); \
    if ((++_sp & 255u) == 0u) { if (xb_ld(&(bar)[XB_TMO])) break; if (_sp > XB_SPIN_CAP) { atomicAdd(&(bar)[XB_TMO], 1u); break; } } } } while (0)
struct XcdBarrier { unsigned* bar; unsigned x; volatile LAS unsigned* st; };
__device__ __forceinline__ XcdBarrier xcd_barrier_post(unsigned* bar, volatile LAS unsigned* st, bool t0) {
    XcdBarrier b; b.bar = bar; b.x = xb_xcc_id(); b.st = st;
    if (t0) (void)xb_add(&bar[XB_XCNT(b.x)], 1u);
    return b;
}
__device__ __forceinline__ void xcd_barrier_complete(unsigned* bar, unsigned x, unsigned& nloc, unsigned& nx) {
    const unsigned G = gridDim.x * gridDim.y * gridDim.z;
    unsigned sum, cnt, mine, sp = 0u;
    for (;;) {
        sum = 0u; cnt = 0u; mine = 0u;
#pragma unroll
        for (unsigned j = 0; j < 16; ++j) { const unsigned c = xb_ld(&bar[XB_XCNT(j)]); sum += c; cnt += (c > 0u) ? 1u : 0u; mine = (j == x) ? c : mine; }
        if (sum == G) break;
        __builtin_amdgcn_s_sleep(1);
        if ((++sp & 255u) == 0u) { if (xb_ld(&bar[XB_TMO])) break; if (sp > XB_SPIN_CAP) { atomicAdd(&bar[XB_TMO], 1u); break; } }
    }
    nloc = mine > 0u ? mine : 1u; nx = cnt > 0u ? cnt : 1u;
}
__device__ __forceinline__ void xcd_barrier(const XcdBarrier& b, bool t0) {
    asm volatile("s_waitcnt vmcnt(0)" ::: "memory");
    __syncthreads();
    if (t0) {
        unsigned* bar = b.bar;
        __builtin_amdgcn_s_waitcnt(0);
        unsigned nloc = b.st[0], nx = b.st[1];
        if (nloc == 0u) { xcd_barrier_complete(bar, b.x, nloc, nx); b.st[0] = nloc; b.st[1] = nx; }
        const unsigned old = xb_add(&bar[XB_XSUB(b.x)], 1u);
        const unsigned gen = old / nloc;
        if (old + 1u == (gen + 1u) * nloc) {
            __builtin_amdgcn_fence(__ATOMIC_RELEASE, "agent");
            asm volatile("s_waitcnt vmcnt(0)" ::: "memory");
            const unsigned og = xb_add(&bar[XB_TOP], 1u);
            const unsigned tg = og / nx;
            if (og + 1u == (tg + 1u) * nx) xb_add(&bar[XB_TOPGEN], 1u);
            else XB_SPIN(xb_ld(&bar[XB_TOPGEN]) == tg, bar);
            __builtin_amdgcn_fence(__ATOMIC_ACQUIRE, "agent");
            xb_add(&bar[XB_XGEN(b.x)], 1u);
            asm volatile("s_waitcnt vmcnt(0)" ::: "memory");
        } else {
            XB_SPIN(xb_ld(&bar[XB_XGEN(b.x)]) == gen, bar);
            __builtin_amdgcn_fence(__ATOMIC_ACQUIRE, "agent");
            asm volatile("s_waitcnt vmcnt(0)" ::: "memory");
        }
    }
    __syncthreads();
}

__device__ __forceinline__ void transpose_item(const float* W, int K, int N, bf16* WT, bool gu, LAS float* scr, int item, int lane) {
    const int nblk = N / 64, kb = item / nblk, nb = item % nblk, k0 = 64 * kb, n0 = 64 * nb;
    int r0 = n0; bool qk = false;
    float wsc = 1.0f;
    if (gu) { const int jj = (n0 < DFF) ? n0 : n0 - DFF; r0 = (jj >> 7) * 256 + (jj & 127) + ((n0 < DFF) ? 0 : 128); wsc = (n0 < DFF) ? 1.44269504089f : 0.69314718056f; }
    if (N == 3072 && n0 < 2048) { qk = true; const int hc = n0 >> 6; r0 = (hc >> 2) * 256 + (hc & 3) * 32; }
    const int n4 = lane & 15, kr = lane >> 4;
    const float* wp = W + (size_t)(k0 + kr) * N + n0 + 4 * n4;
    f32x4 v[16];
#pragma unroll
    for (int i = 0; i < 16; ++i) v[i] = *(const f32x4*)(wp + (size_t)(4 * i) * N);
#pragma unroll
    for (int i = 0; i < 16; ++i) { LAS float* d = scr + (4 * i + kr) * 65 + 4 * n4; d[0] = v[i].x; d[1] = v[i].y; d[2] = v[i].z; d[3] = v[i].w; }
    asm volatile("s_waitcnt lgkmcnt(0)" ::: "memory");
    const int c = lane & 7;
#pragma unroll
    for (int j = 0; j < 8; ++j) { const int n = (lane >> 3) + 8 * j; const LAS float* q = scr + (8 * c) * 65 + n;
        u32x4 o; o.x = pk2(q[0 * 65] * wsc, q[1 * 65] * wsc); o.y = pk2(q[2 * 65] * wsc, q[3 * 65] * wsc); o.z = pk2(q[4 * 65] * wsc, q[5 * 65] * wsc); o.w = pk2(q[6 * 65] * wsc, q[7 * 65] * wsc);
        *(u32x4*)(WT + (size_t)(qk ? (r0 + (n >> 5) * 128 + (n & 31)) : (r0 + n)) * K + k0 + 8 * c) = o; }
    asm volatile("s_waitcnt lgkmcnt(0)" ::: "memory");
}


__device__ __forceinline__ void norm_phase(const float* xsrc, const float* ysrc, const float* ysrc2, const float* gvec, const float* ada, int kshift, bf16* hb, bool with_ctx, int vcu, int NGW, int wv) {
    const int tid = wv * 64 + lane_id_v(); asm volatile("" : "+s"(vcu), "+s"(NGW));
    const int lane = tid & 63, gw = vcu * 8 + __builtin_amdgcn_readfirstlane(tid >> 6);
    const int nrows = with_ctx ? MC : MX, rpw = (nrows + NGW - 1) / NGW, r0 = gw * rpw;
    int prev_s = -1; f32x4 gsv[4], shv[4], vn[4];
#define NORM_ROWPOS(i_, b_, j_) do { if (with_ctx) { b_ = (i_) / TOK; j_ = (i_) % TOK; } else { b_ = (i_) >> 11; j_ = 256 + ((i_) & 2047); } } while (0)
#define NORM_LOAD(i_, dst_) do { int b_, j_; NORM_ROWPOS(i_, b_, j_); \
        if (j_ < CTX) { const f32x4* p_ = (const f32x4*)(ysrc + ((size_t)b_ * CTX + j_) * DM) + lane; _Pragma("unroll") for (int q = 0; q < 4; ++q) dst_[q] = p_[64 * q]; \
            if (ysrc2) { const f32x4* p2_ = (const f32x4*)(ysrc2 + ((size_t)b_ * CTX + j_) * DM) + lane; _Pragma("unroll") for (int q = 0; q < 4; ++q) dst_[q] += p2_[64 * q]; } } \
        else { const f32x4* p_ = (const f32x4*)(xsrc + ((size_t)b_ * SEQ + (j_ - CTX)) * DM) + lane; _Pragma("unroll") for (int q = 0; q < 4; ++q) dst_[q] = p_[64 * q]; } } while (0)
    if (r0 < nrows) NORM_LOAD(r0, vn);
    for (int k = 0; k < rpw; ++k) {
        const int i = r0 + k; if (i >= nrows) break;
        f32x4 v[4];
#pragma unroll
        for (int q = 0; q < 4; ++q) v[q] = vn[q];
        if (k + 1 < rpw && i + 1 < nrows) NORM_LOAD(i + 1, vn);
        int b, j; NORM_ROWPOS(i, b, j);
        const int s = (j < CTX) ? 16 : b;
        if (s != prev_s) { prev_s = s;
            const f32x4* gp = (const f32x4*)gvec + lane; const f32x4* shp = (const f32x4*)(ada + (size_t)(s * 9 + kshift) * DM) + lane; const f32x4* scp = shp + DM / 4;
#pragma unroll
            for (int q = 0; q < 4; ++q) { gsv[q] = gp[64 * q] * (scp[64 * q] + 1.0f); shv[q] = shp[64 * q]; } }
        float ss = 0.f;
#pragma unroll
        for (int q = 0; q < 4; ++q) ss += (v[q].x * v[q].x + v[q].y * v[q].y) + (v[q].z * v[q].z + v[q].w * v[q].w);
        const float rstd = rsqrtf(wave_sum(ss) * (1.f / DM) + EPS);
        u32x2* o8 = (u32x2*)(hb + ((size_t)b * TOK + j) * DM) + lane;
#pragma unroll
        for (int q = 0; q < 4; ++q) { const f32x4 o = v[q] * rstd * gsv[q] + shv[q];
            u32x2 w; w.x = pk2(o.x, o.y); w.y = pk2(o.z, o.w); o8[64 * q] = w; }
    }
#undef NORM_LOAD
#undef NORM_ROWPOS
}

__device__ __forceinline__ void norm_fourier_phase(const float* xsrc, const float* gvec, const float* ada, bf16* hb, float* h1024, int vcu, int NGW, int wv) {
    const int tid = wv * 64 + lane_id_v(); asm volatile("" : "+s"(vcu), "+s"(NGW));
    const int lane = tid & 63, gw = vcu * 8 + __builtin_amdgcn_readfirstlane(tid >> 6);
    const int nit = NB * 1024, ipw = (nit + NGW - 1) / NGW, i0 = gw * ipw;
    int prev_b = -1; f32x4 gsv[4], shv[4], na[4], nb[4];
#define NF_LOAD(i_) do { const int b_ = (i_) >> 10, p_ = (i_) & 1023, p2_ = p_ ? (SEQ - p_) : (SEQ / 2); \
        const f32x4* xa_ = (const f32x4*)(xsrc + ((size_t)b_ * SEQ + p_) * DM) + lane; const f32x4* xb_ = (const f32x4*)(xsrc + ((size_t)b_ * SEQ + p2_) * DM) + lane; \
        _Pragma("unroll") for (int q = 0; q < 4; ++q) { na[q] = xa_[64 * q]; nb[q] = xb_[64 * q]; } } while (0)
    if (i0 < nit) NF_LOAD(i0);
    for (int k = 0; k < ipw; ++k) {
        const int i = i0 + k; if (i >= nit) break;
        const int b = i >> 10, p = i & 1023;
        f32x4 va[4], vb[4];
#pragma unroll
        for (int q = 0; q < 4; ++q) { va[q] = na[q]; vb[q] = nb[q]; }
        if (k + 1 < ipw && i + 1 < nit) NF_LOAD(i + 1);
        if (b != prev_b) { prev_b = b;
            const f32x4* gp = (const f32x4*)gvec + lane; const f32x4* shp = (const f32x4*)(ada + (size_t)(b * 9 + 3) * DM) + lane; const f32x4* scp = shp + DM / 4;
#pragma unroll
            for (int q = 0; q < 4; ++q) { gsv[q] = gp[64 * q] * (scp[64 * q] + 1.0f); shv[q] = shp[64 * q]; } }
        float sa = 0.f, sb = 0.f;
#pragma unroll
        for (int q = 0; q < 4; ++q) { sa += (va[q].x * va[q].x + va[q].y * va[q].y) + (va[q].z * va[q].z + va[q].w * va[q].w); sb += (vb[q].x * vb[q].x + vb[q].y * vb[q].y) + (vb[q].z * vb[q].z + vb[q].w * vb[q].w); }
        const float ra = rsqrtf(wave_sum(sa) * (1.f / DM) + EPS), rb = rsqrtf(wave_sum(sb) * (1.f / DM) + EPS);
        u32x2* oe = (u32x2*)(hb + ((size_t)b * TOK + CTX + p) * DM) + lane; u32x2* oo = (u32x2*)(hb + ((size_t)b * TOK + CTX + 1024 + p) * DM) + lane;
        f32x4* hs = (f32x4*)(h1024 + (size_t)b * DM) + lane;
#pragma unroll
        for (int q = 0; q < 4; ++q) { const f32x4 ha = va[q] * ra * gsv[q] + shv[q], hbv = vb[q] * rb * gsv[q] + shv[q];
            f32x4 e, o;
            if (p) { e = ha + hbv; o = ha - hbv; } else { e = ha; o = (f32x4){0.f, 0.f, 0.f, 0.f}; hs[64 * q] = hbv; }
            u32x2 we, wo; we.x = pk2(e.x, e.y); we.y = pk2(e.z, e.w); wo.x = pk2(o.x, o.y); wo.y = pk2(o.z, o.w);
            oe[64 * q] = we; oo[64 * q] = wo; }
    }
#undef NF_LOAD
}

__device__ __forceinline__ void ada_phase(LAS unsigned char* lds, const float* c, const float* c_ctx, const float* w_mod, const float* b_mod, float* ada, int G, int bid, int wv) {
    const int tid = wv * 64 + lane_id_v();
    LAS float* sc = (LAS float*)lds;
    LAS float* red = (LAS float*)(lds + 17 * 1024 * 4);
    {
        float cv[34];
#pragma unroll
        for (int q = 0; q < 34; ++q) { const int i = tid + 512 * q, s = i >> 10, k = i & 1023; cv[q] = (s < 16) ? c[s * 1024 + k] : c_ctx[k]; }
#pragma unroll
        for (int q = 0; q < 34; ++q) sc[tid + 512 * q] = cv[q] / (1.0f + __expf(-cv[q]));
    }
    __syncthreads();
    const int lane = tid & 63, w = tid >> 6, n4 = lane & 15, kr = lane >> 4;
    for (int item = bid; item < 288; item += G) {
        const int layer = item / 144, c0 = (item % 144) * 64;
        const float* W = w_mod + (size_t)layer * 1024 * NMOD + (size_t)(w * 128 + kr) * NMOD + c0 + 4 * n4;
        const LAS float* scp = sc + w * 128 + kr;
        f32x4 acc[17];
#pragma unroll
        for (int s = 0; s < 17; ++s) acc[s] = (f32x4){0.f, 0.f, 0.f, 0.f};
        for (int st0 = 0; st0 < 32; st0 += 8) {
            f32x4 wv[8];
#pragma unroll
            for (int u = 0; u < 8; ++u) wv[u] = *(const f32x4*)(W + (size_t)(4 * (st0 + u)) * NMOD);
#pragma unroll
            for (int u = 0; u < 8; ++u) {
#pragma unroll
                for (int s = 0; s < 17; ++s) acc[s] += wv[u] * scp[s * 1024 + 4 * (st0 + u)];
                __builtin_amdgcn_sched_barrier(0); } }
#pragma unroll
        for (int s = 0; s < 17; ++s)
#pragma unroll
            for (int e = 0; e < 4; ++e) { float v = acc[s][e]; v += __shfl_xor(v, 16); v += __shfl_xor(v, 32); if (lane < 16) red[(w * 17 + s) * 64 + 4 * n4 + e] = v; }
        __syncthreads();
        for (int o = tid; o < 17 * 64; o += 512) { const int s = o >> 6, cc = o & 63; float sum = 0.f;
#pragma unroll
            for (int q = 0; q < 8; ++q) sum += red[(q * 17 + s) * 64 + cc];
            ada[(size_t)(layer * 17 + s) * NMOD + c0 + cc] = sum + b_mod[layer * NMOD + c0 + cc]; }
        __syncthreads();
    }
}

__device__ __forceinline__ void qknorm_phase(bf16* Qr, bf16* Kr, const float* qg, const float* kg, const f32x2* rope, int vcu, int NGW, int wv) {
    const int tid = wv * 64 + lane_id_v(); asm volatile("" : "+s"(vcu), "+s"(NGW));
    const int lane = tid & 63, gw = vcu * 8 + __builtin_amdgcn_readfirstlane(tid >> 6);
    for (int it = gw; it < MC * 2; it += NGW) {
        const int r = it >> 1, which = it & 1, b = r / TOK, j = r % TOK;
        if (j < CTX && which == 0) continue;
        bf16* p = (which ? Kr : Qr) + (size_t)r * DM + lane * 16;
        const u32x4 w0 = *(const u32x4*)p, w1 = *(const u32x4*)(p + 8);
        float v[16];
        v[0] = bf_lo(w0.x); v[1] = bf_hi(w0.x); v[2] = bf_lo(w0.y); v[3] = bf_hi(w0.y); v[4] = bf_lo(w0.z); v[5] = bf_hi(w0.z); v[6] = bf_lo(w0.w); v[7] = bf_hi(w0.w);
        v[8] = bf_lo(w1.x); v[9] = bf_hi(w1.x); v[10] = bf_lo(w1.y); v[11] = bf_hi(w1.y); v[12] = bf_lo(w1.z); v[13] = bf_hi(w1.z); v[14] = bf_lo(w1.w); v[15] = bf_hi(w1.w);
        float ss = 0.f;
#pragma unroll
        for (int i = 0; i < 16; ++i) ss += v[i] * v[i];
        ss += shx<1>(ss); ss += shx<2>(ss);
        const float rstd = rsqrtf(ss * (1.f / 64.f) + EPS);
        const float* gn = (which ? kg : qg) + (lane & 3) * 16;
#pragma unroll
        for (int i = 0; i < 16; ++i) v[i] = v[i] * rstd * gn[i];
        if (j >= CTX) {
            const int pos = j - CTX, axis = (lane >> 1) & 1, half = lane & 1;
            const f32x2* cs = rope + ((size_t)pos * 2 + axis) * 16;
#pragma unroll
            for (int i = 0; i < 16; ++i) { const float pv = shx<1>(v[i]); const f32x2 t = cs[i];
                v[i] = half ? (v[i] * t.x + pv * t.y) : (v[i] * t.x - pv * t.y); }
        }
        if (which == 0) {
#pragma unroll
            for (int i = 0; i < 16; ++i) v[i] *= QSCALE;
        }
        u32x4 o0, o1;
        o0.x = pk2(v[0], v[1]); o0.y = pk2(v[2], v[3]); o0.z = pk2(v[4], v[5]); o0.w = pk2(v[6], v[7]);
        o1.x = pk2(v[8], v[9]); o1.y = pk2(v[10], v[11]); o1.z = pk2(v[12], v[13]); o1.w = pk2(v[14], v[15]);
        *(u32x4*)p = o0; *(u32x4*)(p + 8) = o1;
    }
}

constexpr int AT_ROW = 144, AT_SLOT = 128 * AT_ROW  , AT_K = 0, AT_V = 3 * AT_SLOT  , AT_X = 0, AT_OUT = 5 * AT_SLOT  , AT_OROW = 272;
__device__ __forceinline__ int crow(int i, int h) { return (i & 3) + 8 * (i >> 2) + 4 * h; }
#define MFMA32(a, b, c) __builtin_amdgcn_mfma_f32_32x32x16_bf16((a), (b), (c), 0, 0, 0)
__device__ __forceinline__ void attn_phase(LAS unsigned char* lds, const bf16* Q, const bf16* Kt, const bf16* VT, bf16* O, float out_scale, int G, int bid, int wv) {
    const int tid = wv * 64 + lane_id_v();
    const int lane = tid & 63, r = lane & 31, h = lane >> 5, wid = __builtin_amdgcn_readfirstlane(tid >> 6), c = wid & 1, qg = wid >> 1;
    asm volatile("" : "+s"(bid), "+s"(G));
    const int vcu = (G % 8 == 0) ? (bid % 8) * (G / 8) + bid / 8 : bid;
    const int srow2 = (tid & 255) >> 3, spart = tid & 7; const bool lead = wid < 4;
    const int rsw = (r & 19) | ((r & 4) << 1) | ((r & 8) >> 1);
    const int koff = AT_K + (c * 64 + rsw) * AT_ROW + h * 16, voff = AT_V + r * AT_ROW + h * 16;
    const int sdst = srow2 * AT_ROW + spart * 16;
    constexpr int NT = TOK / 64;
    f32x16 zero16;
#pragma unroll
    for (int i = 0; i < 16; ++i) zero16[i] = 0.f;
#define AT_BAR() do { asm volatile("s_waitcnt lgkmcnt(0)" ::: "memory"); __builtin_amdgcn_s_barrier(); asm volatile("" ::: "memory"); } while (0)
    for (int unit = vcu; unit < NB * 8 * 16; unit += G) {
        const int bh = unit >> 4, qb = unit & 15, b = bh >> 3, hh = bh & 7, q0 = qb * 128;
        const bf16* qp = Q + ((size_t)b * TOK + CTX + q0 + qg * 32 + r) * DM + hh * 128 + c * 64 + h * 8;
        bf16x8 qf[4];
#pragma unroll
        for (int d0 = 0; d0 < 4; ++d0) qf[d0] = *(const bf16x8*)(qp + d0 * 16);
        const bf16* g0 = lead ? Kt + ((size_t)b * TOK + srow2) * DM + hh * 128 + spart * 8 : VT + ((size_t)(b * 1024 + hh * 128 + srow2)) * TOK + spart * 8;
        const size_t go1 = lead ? (size_t)32 * DM : (size_t)32 * TOK, go2 = lead ? (size_t)64 : (size_t)64 * TOK, go3 = go1 + go2;
        const int gstep = lead ? 64 * DM : 64;
        f32x16 o[4];
#pragma unroll
        for (int d = 0; d < 4; ++d)
#pragma unroll
            for (int i = 0; i < 16; ++i) o[d][i] = 0.f;
        float lsum0 = 0.f, lsum1 = 0.f;
        u32x4 st[4];
        {
            const u32x4 a0 = *(const u32x4*)(g0), a1 = *(const u32x4*)(g0 + go1), a2 = *(const u32x4*)(g0 + go2), a3 = *(const u32x4*)(g0 + go3);
            const int d0 = (lead ? AT_K : AT_V) + sdst;
            *(LAS u32x4*)(lds + d0) = a0; *(LAS u32x4*)(lds + d0 + 32 * AT_ROW) = a1; *(LAS u32x4*)(lds + d0 + 64 * AT_ROW) = a2; *(LAS u32x4*)(lds + d0 + 96 * AT_ROW) = a3;
            if (lead) { const bf16* g1 = g0 + gstep; const u32x4 b0 = *(const u32x4*)(g1), b1 = *(const u32x4*)(g1 + go1), b2 = *(const u32x4*)(g1 + go2), b3 = *(const u32x4*)(g1 + go3);
                const int d1 = AT_K + AT_SLOT + sdst;
                *(LAS u32x4*)(lds + d1) = b0; *(LAS u32x4*)(lds + d1 + 32 * AT_ROW) = b1; *(LAS u32x4*)(lds + d1 + 64 * AT_ROW) = b2; *(LAS u32x4*)(lds + d1 + 96 * AT_ROW) = b3; }
        }
        __syncthreads();
        f32x16 sc0, sc1, sn0, sn1;
        {
            sc0 = zero16; sc1 = zero16;
#pragma unroll
            for (int d0 = 0; d0 < 4; ++d0) { const bf16x8 k0 = *(const LAS bf16x8*)(lds + koff + d0 * 32), k1 = *(const LAS bf16x8*)(lds + koff + 32 * AT_ROW + d0 * 32);
                sc0 = MFMA32(k0, qf[d0], sc0); sc1 = MFMA32(k1, qf[d0], sc1); }
        }
        if (!lead) AT_BAR();
        int ks_next = AT_SLOT, ks_fill = 2 * AT_SLOT;
#define SEQ_MV __builtin_amdgcn_sched_group_barrier(0x100, 4, 0); _Pragma("unroll") for (int q = 0; q < 4; ++q) { __builtin_amdgcn_sched_group_barrier(0x8, 1, 0); __builtin_amdgcn_sched_group_barrier(0x100, 1, 0); __builtin_amdgcn_sched_group_barrier(0x402, 5, 0); } _Pragma("unroll") for (int q = 0; q < 4; ++q) { __builtin_amdgcn_sched_group_barrier(0x8, 1, 0); __builtin_amdgcn_sched_group_barrier(0x402, 5, 0); }
#define SEQ_M __builtin_amdgcn_sched_group_barrier(0x100, 4, 0); _Pragma("unroll") for (int q = 0; q < 4; ++q) { __builtin_amdgcn_sched_group_barrier(0x8, 1, 0); __builtin_amdgcn_sched_group_barrier(0x100, 1, 0); } __builtin_amdgcn_sched_group_barrier(0x8, 4, 0);
#define ATT_BODY(HAS_NEXT, C0, C1, N0, N1) do { \
            const int vs = (t & 1) * AT_SLOT; \
            if (HAS_NEXT) { const int tk = lead ? ((t + 2 < NT) ? t + 2 : NT - 1) : t + 1; const bf16* g = g0 + (size_t)tk * gstep; \
                st[0] = *(const u32x4*)(g); st[1] = *(const u32x4*)(g + go1); st[2] = *(const u32x4*)(g + go2); st[3] = *(const u32x4*)(g + go3); } \
            bf16x8 pf[2][2]; \
            {   \
                bf16x8 kf[2][4]; \
                if (HAS_NEXT) { _Pragma("unroll") for (int d0 = 0; d0 < 4; ++d0) { kf[0][d0] = *(const LAS bf16x8*)(lds + ks_next + koff + d0 * 32); kf[1][d0] = *(const LAS bf16x8*)(lds + ks_next + koff + 32 * AT_ROW + d0 * 32); } \
                    N0 = MFMA32(kf[0][0], qf[0], zero16); N1 = MFMA32(kf[1][0], qf[0], zero16); \
                    _Pragma("unroll") for (int d0 = 1; d0 < 4; ++d0) { N0 = MFMA32(kf[0][d0], qf[d0], N0); N1 = MFMA32(kf[1][d0], qf[d0], N1); } } \
                _Pragma("unroll") for (int i = 0; i < 16; i += 2) { C0[i] = __builtin_amdgcn_exp2f(C0[i]); C0[i + 1] = __builtin_amdgcn_exp2f(C0[i + 1]); lsum0 += C0[i]; lsum1 += C0[i + 1]; } \
                _Pragma("unroll") for (int sx = 0; sx < 2; ++sx) { u32x4 w; w.x = pk2(C0[8 * sx], C0[8 * sx + 1]); w.y = pk2(C0[8 * sx + 2], C0[8 * sx + 3]); w.z = pk2(C0[8 * sx + 4], C0[8 * sx + 5]); w.w = pk2(C0[8 * sx + 6], C0[8 * sx + 7]); pf[0][sx] = __builtin_bit_cast(bf16x8, w); } \
                if (HAS_NEXT) { SEQ_MV } \
            } \
            __builtin_amdgcn_sched_barrier(0); \
            AT_BAR(); \
            {   \
                bf16x8 vf[4][2]; \
                _Pragma("unroll") for (int sx = 0; sx < 2; ++sx) _Pragma("unroll") for (int dvb = 0; dvb < 4; ++dvb) vf[dvb][sx] = *(const LAS bf16x8*)(lds + vs + voff + dvb * 32 * AT_ROW + sx * 32); \
                _Pragma("unroll") for (int sx = 0; sx < 2; ++sx) _Pragma("unroll") for (int dvb = 0; dvb < 4; ++dvb) o[dvb] = MFMA32(vf[dvb][sx], pf[0][sx], o[dvb]); \
                _Pragma("unroll") for (int i = 0; i < 16; i += 2) { C1[i] = __builtin_amdgcn_exp2f(C1[i]); C1[i + 1] = __builtin_amdgcn_exp2f(C1[i + 1]); lsum0 += C1[i]; lsum1 += C1[i + 1]; } \
                _Pragma("unroll") for (int sx = 0; sx < 2; ++sx) { u32x4 w; w.x = pk2(C1[8 * sx], C1[8 * sx + 1]); w.y = pk2(C1[8 * sx + 2], C1[8 * sx + 3]); w.z = pk2(C1[8 * sx + 4], C1[8 * sx + 5]); w.w = pk2(C1[8 * sx + 6], C1[8 * sx + 7]); pf[1][sx] = __builtin_bit_cast(bf16x8, w); } \
                SEQ_MV \
            } \
            __builtin_amdgcn_sched_barrier(0); \
            {   \
                bf16x8 vf[4][2]; \
                _Pragma("unroll") for (int sx = 0; sx < 2; ++sx) _Pragma("unroll") for (int dvb = 0; dvb < 4; ++dvb) vf[dvb][sx] = *(const LAS bf16x8*)(lds + vs + voff + dvb * 32 * AT_ROW + 64 + sx * 32); \
                _Pragma("unroll") for (int sx = 0; sx < 2; ++sx) _Pragma("unroll") for (int dvb = 0; dvb < 4; ++dvb) o[dvb] = MFMA32(vf[dvb][sx], pf[1][sx], o[dvb]); \
                SEQ_M \
            } \
            if (HAS_NEXT) { const int dd = (lead ? ks_fill : AT_V + (AT_SLOT - vs)) + sdst; \
                *(LAS u32x4*)(lds + dd) = st[0]; *(LAS u32x4*)(lds + dd + 32 * AT_ROW) = st[1]; *(LAS u32x4*)(lds + dd + 64 * AT_ROW) = st[2]; *(LAS u32x4*)(lds + dd + 96 * AT_ROW) = st[3]; } \
            AT_BAR(); \
            if (HAS_NEXT) { const int tmp = ks_next; ks_next = ks_fill; ks_fill = (tmp == 0) ? 2 * AT_SLOT : tmp - AT_SLOT; } \
        } while (0)
        int t = 0;
        for (; t < NT - 2; t += 2) { ATT_BODY(true, sc0, sc1, sn0, sn1); ++t; ATT_BODY(true, sn0, sn1, sc0, sc1); --t; }
        ATT_BODY(true, sc0, sc1, sn0, sn1); ++t;
        ATT_BODY(false, sn0, sn1, sc0, sc1);
#undef ATT_BODY
#undef SEQ_MV
#undef SEQ_M
        if (lead) AT_BAR();
        const float lsum = lsum0 + lsum1;
        KArgs ka = KA(); const float lam = P_SCAL[0]; const float* sub_g = ka->in[19];
        const float l = add_x32(lsum);
        LAS float* X = (LAS float*)(lds + AT_X);
        if (c == 1) { const float f = lam / l;
#pragma unroll
            for (int dvb = 0; dvb < 4; ++dvb)
#pragma unroll
                for (int i = 0; i < 16; ++i) X[(qg * 128 + dvb * 32 + crow(i, h)) * 32 + r] = o[dvb][i] * f; }
        __syncthreads();
        if (c == 0) { const float f = 1.0f / l; float ss = 0.f;
#pragma unroll
            for (int dvb = 0; dvb < 4; ++dvb)
#pragma unroll
                for (int i = 0; i < 16; ++i) { const float v = o[dvb][i] * f - X[(qg * 128 + dvb * 32 + crow(i, h)) * 32 + r]; o[dvb][i] = v; ss += v * v; }
            ss = add_x32(ss);
            const float rstd = rsqrtf(ss * (1.f / 128.f) + EPS) * out_scale;
#pragma unroll
            for (int dvb = 0; dvb < 4; ++dvb)
#pragma unroll
                for (int i4 = 0; i4 < 4; ++i4) { const int dv = dvb * 32 + 8 * i4 + 4 * h; const f32x4 sg = *(const f32x4*)(sub_g + dv);
                    u32x2 w; w.x = pk2(o[dvb][4 * i4] * rstd * sg.x, o[dvb][4 * i4 + 1] * rstd * sg.y); w.y = pk2(o[dvb][4 * i4 + 2] * rstd * sg.z, o[dvb][4 * i4 + 3] * rstd * sg.w);
                    *(LAS u32x2*)(lds + AT_OUT + (qg * 32 + r) * AT_OROW + dv * 2) = w; } }
        __syncthreads();
#pragma unroll
        for (int i = 0; i < 4; ++i) { const int ch = tid + 512 * i, row = ch >> 4, part = ch & 15;
            const u32x4 v = *(const LAS u32x4*)(lds + AT_OUT + row * AT_OROW + part * 16);
            *(u32x4*)(O + ((size_t)b * TOK + CTX + q0 + row) * DM + hh * 128 + part * 8) = v; }
    }
    __syncthreads();
}

__global__ void __launch_bounds__(512, 2) fwd_kernel(Args args) {
    extern __shared__ __attribute__((aligned(16))) unsigned char lds_raw[];
    LAS unsigned char* lds = (LAS unsigned char*)lds_raw;
    cg::grid_group grid = cg::this_grid();
    const int G = gridDim.x, bid = blockIdx.x;
    const int wv = __builtin_amdgcn_readfirstlane(threadIdx.x >> 6);
    const int vcu = (G % 8 == 0) ? (bid % 8) * (G / 8) + bid / 8 : bid;
    const int NGW = G * 8;
    const int lo = args.ph_lo, hi = args.ph_hi;
    int ph = 0;
    volatile LAS unsigned* bst = (volatile LAS unsigned*)(lds + LDS_BYTES - 64);
    { const int tid = wv * 64 + lane_id_v(); if (tid < 2) bst[tid] = 0u; __syncthreads(); }
    if (lo < 0) grid.sync();
    unsigned xcc;
    { KArgs kb = KA(); xcc = xcd_barrier_post((unsigned*)kb->ws, bst, wv == 0 && lane_id_v() == 0).x; }
#ifdef TPROBE
    unsigned long long tp1 = __builtin_amdgcn_s_memrealtime(), tp2 = 0; int tpn = 0;
#define TP_MARK() do { ++tpn; if (tpn == TPROBE) tp1 = __builtin_amdgcn_s_memrealtime(); if (tpn == TPROBE + 1) tp2 = __builtin_amdgcn_s_memrealtime(); } while (0)
#else
#define TP_MARK() do {} while (0)
#endif
#ifndef REP_MASK
#define REP_MASK 0
#endif
#define NREP(k) (((REP_MASK >> (k)) & 1) ? 2 : 1)
#define RUN() (lo <= ph && ph < hi)
#define XBAR() do { KArgs kb = KA(); XcdBarrier xb_; xb_.bar = (unsigned*)kb->ws; xb_.x = xcc; xb_.st = bst; xcd_barrier(xb_, wv == 0 && lane_id_v() == 0); } while (0)
#define SEAM() do { if (lo <= ph && ph + 1 < hi) { XBAR(); if ((REP_MASK >> 6) & 1) { XBAR(); } } ++ph; TP_MARK(); } while (0)

    if (RUN()) for (int rep = 0; rep < NREP(0); ++rep) {
        if (rep) XBAR();
        KArgs ka = KA();
        for (int r2 = 0; r2 < NREP(8); ++r2) ada_phase(lds, ka->in[1], ka->in[3], ka->in[5], ka->in[6], P_ADA, G, bid, wv);
        const int tid = wv * 64 + lane_id_v();
        const int lane = tid & 63, wave = wv, gw = vcu * 8 + wave;
        LAS float* scr = (LAS float*)(lds + wave * 16640);
        constexpr int I_GU = 16 * 88, I_D = 44 * 16, I_QKV = 16 * 48, I_O = 16 * 16;
        constexpr int NITEMS = 4 * I_GU + 4 * I_D + I_QKV + 2 * I_O;
        for (int r2 = 0; r2 < NREP(9); ++r2)
        for (int it = gw; it < NITEMS; it += NGW) {
            int q = it;
            if (q < 4 * I_GU) { const int f = q / I_GU; transpose_item(((f & 1) ? ka->in[9] : ka->in[7]) + (size_t)(f >> 1) * DM * NGU, DM, NGU, (bf16*)(P_WS + WS_WGU + f * WGU_SZ), true, scr, q % I_GU, lane); continue; } q -= 4 * I_GU;
            if (q < 4 * I_D) { const int f = q / I_D; transpose_item(((f & 1) ? ka->in[10] : ka->in[8]) + (size_t)(f >> 1) * DFF * DM, DFF, DM, (bf16*)(P_WS + WS_WD + f * WD_SZ), false, scr, q % I_D, lane); continue; } q -= 4 * I_D;
            if (q < I_QKV) { transpose_item(ka->in[11], DM, 3072, P_WQKV, false, scr, q, lane); continue; } q -= I_QKV;
            if (q < I_O) { transpose_item(ka->in[12], DM, DM, P_WO, false, scr, q, lane); continue; } q -= I_O;
            transpose_item(ka->in[20], DM, DM, P_WF, false, scr, q, lane);
        }
        const int gt = vcu * 512 + tid, NGT = G * 512;
        for (int r2 = 0; r2 < NREP(10); ++r2)
        for (int i = gt; i < 2048 * 256; i += NGT) { const int k = i >> 8, j0 = (i & 255) * 8; const bool isS = j0 >= 1024; const int jj = j0 & 1023;
            float v[8];
#pragma unroll
            for (int e = 0; e < 8; ++e) { const int idx = (k * (jj + e)) & 2047; float sn, cs; sincospif((float)idx * (1.0f / 1024.0f), &sn, &cs); v[e] = (isS ? -sn : cs) * 0.02209708691f; }
            u32x4 w; w.x = pk2(v[0], v[1]); w.y = pk2(v[2], v[3]); w.z = pk2(v[4], v[5]); w.w = pk2(v[6], v[7]);
            *(u32x4*)(P_DFTS + (size_t)k * 2048 + j0) = w; }
        for (int i = gt; i < 512 * 32; i += NGT) { const int f = i >> 5, c0 = (i & 31) * 8; const bool isS = f >= 256; const int ff = f & 255;
            float v[8];
#pragma unroll
            for (int e = 0; e < 8; ++e) { const int idx = (ff * (c0 + e)) & 255; float sn, cs; sincospif((float)idx * (1.0f / 128.0f), &sn, &cs); v[e] = (isS ? sn : cs) * 0.0625f; }
            u32x4 w; w.x = pk2(v[0], v[1]); w.y = pk2(v[2], v[3]); w.z = pk2(v[4], v[5]); w.w = pk2(v[6], v[7]);
            *(u32x4*)(P_DFTC + (size_t)f * 256 + c0) = w; }
        if (bid == 0 && wave == 0) {
            float p1 = wave_sum(ka->in[15][lane] * ka->in[16][lane]), p2 = wave_sum(ka->in[17][lane] * ka->in[18][lane]);
            float mq = fabsf(ka->in[13][lane]), mk = fabsf(ka->in[14][lane]);
#pragma unroll
            for (int o = 1; o < 64; o <<= 1) { mq = fmaxf(mq, __shfl_xor(mq, o)); mk = fmaxf(mk, __shfl_xor(mk, o)); }
            if (lane == 0) { P_SCAL[0] = expf(p1) - expf(p2) + 0.2f; P_SCAL[1] = 8.0f * mq * mk * 1.44269504089f; }
        }
    }
    SEAM();

    for (int fi = 0; fi < 4; ++fi) {
#define FI() int fi_ = fi; asm volatile("" : "+s"(fi_)); const int layer = fi_ >> 1, which = fi_ & 1; const bool with_ctx = (fi_ == 0); (void)layer; (void)which; (void)with_ctx
        if (RUN()) for (int rep = 0; rep < NREP(1); ++rep) { KArgs ka = KA(); FI();
            norm_phase((fi_ == 0) ? ka->in[0] : (const float*)P_OUT, ka->in[2], nullptr, ka->in[4] + (size_t)(layer * 3 + which * 2) * DM, P_ADA + (size_t)layer * 17 * NMOD, which * 6, P_HB, with_ctx, vcu, NGW, wv); }
        SEAM();
        if (RUN()) for (int rep = 0; rep < NREP(2); ++rep) {
            if (rep) XBAR();
            KArgs ka = KA(); FI();
            pg8::Gemm g{P_HB, (const bf16*)(P_WS + WS_WGU + fi_ * WGU_SZ), DM, DM, DM, 0u, 0u};
            pg8::Order S; S.init(with_ctx ? 144 : 128, 22, 1, with_ctx ? 0 : 1, 0, G, bid);
            pg8::EpiSwiglu E{P_BIG};
            pg8::gemm_phase<pg8::EpiSwiglu, pg8::Order>(lds, g, S, E, wv);
        }
        SEAM();
        if (RUN()) { KArgs ka = KA(); FI();
            pg8::Gemm g{P_BIG, (const bf16*)(P_WS + WS_WD + fi_ * WD_SZ), DFF, DFF, DFF, 0u, 0u};
            pg8::Order S; S.init(128, 4, 1, 1, 0, G, bid); if (with_ctx) S.ctxsplit = 128;
            pg8::EpiGateRes E{fi_ == 0 ? 1 : 0, layer, which * 6 + 2, 0.5f};
            pg8::gemm_phase<pg8::EpiGateRes, pg8::Order>(lds, g, S, E, wv);
        }
#ifdef TPROBE
        SEAM();
#else
        if (fi < 3) SEAM();
#endif
        if ((fi & 1) == 0) {
            if (RUN()) for (int rep = 0; rep < NREP(7); ++rep) { KArgs ka = KA(); FI();
                if (layer == 0) norm_phase(P_OUT, P_Y1, P_Y1B, ka->in[4] + (size_t)(layer * 3 + 1) * DM, P_ADA + (size_t)layer * 17 * NMOD, 3, P_HB, true, vcu, NGW, wv);
                else norm_fourier_phase(P_OUT, ka->in[4] + (size_t)(layer * 3 + 1) * DM, P_ADA + (size_t)layer * 17 * NMOD, P_HB, (float*)(P_WS + WS_H1024), vcu, NGW, wv); }
            SEAM();
            if (fi == 0) {
                if (RUN()) for (int rep = 0; rep < NREP(5); ++rep) {
                    if (rep) XBAR();
                    { KArgs ka = KA();
                        pg8::Gemm g{P_HB, P_WQKV, DM, DM, DM, 0, 0}; pg8::Order S; S.init(128, 4, 1, 1, 0, G, bid); pg8::EpiQKV E{1};
                        pg8::gemm_phase<pg8::EpiQKV, pg8::Order>(lds, g, S, E, wv); }
                    { KArgs ka = KA();
                        const bf16* WK = P_WQKV + (size_t)1024 * DM; const bf16* WV = P_WQKV + (size_t)2048 * DM;
                        pg8::Gemm g{P_HB, WK, DM, DM, DM, (long long)((const char*)WV - (const char*)P_HB), (long long)((const char*)P_HB - (const char*)WK)};
                        pg8::Order S; S.init(144, 4, 2, 0, 0, G, bid); S.swapg = 1; pg8::EpiQKV E{2};
                        pg8::gemm_phase<pg8::EpiQKV, pg8::Order>(lds, g, S, E, wv); }
                }
                SEAM();
                if (RUN()) for (int rep = 0; rep < NREP(3); ++rep) { KArgs ka = KA();
                    attn_phase(lds, P_BIG, P_BIG + QK_STRIDE, P_BIG + 2 * QK_STRIDE, P_HB, 0.8f, G, bid, wv); }
                SEAM();
            } else {
                if (RUN()) for (int rep = 0; rep < NREP(4); ++rep) {
                    if (rep) XBAR();
                    KArgs ka = KA();
                    pg8::Gemm g{P_DFTC, P_HB, 256, 256, DM, 0u, 512u};
                    pg8::Order S; S.init(1, 128, 4, 0, 1, G, bid); S.chan = 1;
                    pg8::EpiChan E{P_BIG};
                    pg8::gemm_phase<pg8::EpiChan, pg8::Order>(lds, g, S, E, wv);
                    {   KArgs ka = KA();
                        const int tid = wv * 64 + lane_id_v();
                        for (int i8 = vcu * 512 + tid; i8 < NB * 1024 * 8; i8 += G * 512) { const int i = i8 >> 3, part = i8 & 7, b = i >> 10, chn = i & 1023, gq = chn >> 8, m = chn & 255;
                            const f32x4* hp = (const f32x4*)((const float*)(P_WS + WS_H1024) + (size_t)b * DM + gq * 256) + 8 * part; const u32x2* cp = (const u32x2*)(P_DFTC + (size_t)m * 256) + 8 * part;
                            f32x4 hv[8]; u32x2 cw[8];
#pragma unroll
                            for (int c4 = 0; c4 < 8; ++c4) { hv[c4] = hp[c4]; cw[c4] = cp[c4]; }
                            float sum = 0.f;
#pragma unroll
                            for (int c4 = 0; c4 < 8; ++c4) sum += hv[c4].x * bf_lo(cw[c4].x) + hv[c4].y * bf_hi(cw[c4].x) + hv[c4].z * bf_lo(cw[c4].y) + hv[c4].w * bf_hi(cw[c4].y);
                            sum += shx<1>(sum); sum += shx<2>(sum); sum += shx<4>(sum);
                            if (part == 0) ((float*)(P_WS + WS_T))[i] = sum * 0.02209708691f; }
                    }
                }
                SEAM();
                if (RUN()) for (int rep = 0; rep < NREP(4); ++rep) {
                    if (rep) XBAR();
                    KArgs ka = KA();
                    pg8::Gemm g{P_DFTS, P_BIG, 2048, 2048, 2048, 0u, 0u};
                    pg8::Order S; S.init(8, 64, 1, 0, 0, G, bid);
                    pg8::EpiSeq E{P_HB + (size_t)CTX * DM, (const float*)(P_WS + WS_T)};
                    pg8::gemm_phase<pg8::EpiSeq, pg8::Order>(lds, g, S, E, wv);
                }
                SEAM();
            }
            if (RUN()) { KArgs ka = KA(); FI();
                pg8::Gemm g{P_HB, layer == 0 ? P_WO : P_WF, DM, DM, DM, 0u, 0u};
                pg8::Order S; S.init(128, 4, 1, 1, 0, G, bid);
                pg8::EpiGateRes E{0, layer, 5, 1.0f};
                pg8::gemm_phase<pg8::EpiGateRes, pg8::Order>(lds, g, S, E, wv);
            }
            SEAM();
        }
    }
#ifdef TPROBE
    XBAR();
    if (bid == 0 && wv == 0 && lane_id_v() == 0) { KArgs ka = KA(); const float us = (float)(tp2 - tp1) * 0.01f; P_OUT[0] += us * (1.0f / TPSCALE); }
#endif
#undef RUN
#undef SEAM
}

extern "C" void kernel_launch(void* const* d_in, const int* in_sizes, int n_in, void* d_out, int out_size, void* d_ws, size_t ws_size, hipStream_t stream) {
    static int grid = 0;
    if (grid == 0) {
        if (n_in != 21 || ws_size < WS_END) { fprintf(stderr, "kernel_launch: unexpected n_in %d / ws %zu\n", n_in, ws_size); grid = -1; return; }
        int dev = 0, cus = 0, per_cu = 0;
        hipGetDevice(&dev); hipDeviceGetAttribute(&cus, hipDeviceAttributeMultiprocessorCount, dev);
        if (hipFuncSetAttribute((const void*)fwd_kernel, hipFuncAttributeMaxDynamicSharedMemorySize, LDS_BYTES) != hipSuccess) { fprintf(stderr, "kernel_launch: hipFuncSetAttribute failed\n"); grid = -1; return; }
        if (hipOccupancyMaxActiveBlocksPerMultiprocessor(&per_cu, (const void*)fwd_kernel, 512, LDS_BYTES) != hipSuccess || per_cu < 1) { fprintf(stderr, "kernel_launch: occupancy query gave %d\n", per_cu); per_cu = 1; }
        (void)hipGetLastError();
        grid = cus * per_cu;
    }
    if (grid < 0) return;
    if (hipMemsetAsync(d_ws, 0, 16384, stream) != hipSuccess) { fprintf(stderr, "kernel_launch: hipMemsetAsync failed\n"); return; }
    Args a{};
    for (int i = 0; i < 21; ++i) a.in[i] = (const float*)d_in[i];
    a.out = (float*)d_out; a.ws = (unsigned char*)d_ws; a.ph_lo = 0; a.ph_hi = 1000;
    void* kargs[] = {&a};
    hipError_t e = hipLaunchCooperativeKernel((const void*)fwd_kernel, dim3(grid), dim3(512), kargs, LDS_BYTES, stream);
    if (e != hipSuccess) fprintf(stderr, "cooperative launch failed: %s (grid %d)\n", hipGetErrorString(e), grid);
}
```

```cpp
#include <hip/hip_runtime.h>
#include <hip/hip_cooperative_groups.h>
#include <cstdio>
#include <cstdint>
namespace cg = cooperative_groups;

#define LAS __attribute__((address_space(3)))
typedef unsigned short bf16;
typedef short bf16x8 __attribute__((ext_vector_type(8)));
typedef float f32x4 __attribute__((ext_vector_type(4)));
typedef float f32x2 __attribute__((ext_vector_type(2)));
typedef float f32x16 __attribute__((ext_vector_type(16)));
typedef unsigned u32x4 __attribute__((ext_vector_type(4)));
typedef unsigned u32x2 __attribute__((ext_vector_type(2)));
typedef __bf16 bf16x2_t __attribute__((ext_vector_type(2)));

__device__ __forceinline__ unsigned pk2(float lo, float hi) { f32x2 v = {lo, hi}; bf16x2_t b = __builtin_convertvector(v, bf16x2_t); return __builtin_bit_cast(unsigned, b); }
__device__ __forceinline__ float bf_lo(unsigned w) { return __uint_as_float(w << 16); }
__device__ __forceinline__ float bf_hi(unsigned w) { return __uint_as_float(w & 0xffff0000u); }
__device__ __forceinline__ int lane_id_v() { int l; asm volatile("v_mbcnt_lo_u32_b32 %0, -1, 0\n\tv_mbcnt_hi_u32_b32 %0, -1, %0" : "=v"(l)); return l; }
template <int M> __device__ __forceinline__ float shx(float v) { return __builtin_bit_cast(float, __builtin_amdgcn_ds_swizzle(__builtin_bit_cast(int, v), (M << 10) | 0x1f)); }
__device__ __forceinline__ float add_x32(float v) { const unsigned u = __builtin_bit_cast(unsigned, v); auto rr = __builtin_amdgcn_permlane32_swap(u, u, false, false); return __uint_as_float(rr[0]) + __uint_as_float(rr[1]); }
__device__ __forceinline__ float wave_sum(float v) { v += shx<1>(v); v += shx<2>(v); v += shx<4>(v); v += shx<8>(v); v += shx<16>(v); return add_x32(v); }

constexpr int DM = 1024, NB = 16, SEQ = 2048, CTX = 256, TOK = 2304, MC = NB * TOK  , MX = NB * SEQ  , DFF = 2816, NGU = 5632, NMOD = 9216;
constexpr float EPS = 1e-6f;
constexpr float QSCALE = 0.125f * 1.44269504089f;
constexpr size_t MiB = 1u << 20;
constexpr size_t WS_ADA = 1 * MiB;
constexpr size_t WS_SCAL = 3 * MiB;
constexpr size_t WS_ROPE = 3 * MiB + 4096;
constexpr size_t WS_H1024 = 3 * MiB + 640 * 1024;
constexpr size_t WS_T = 3 * MiB + 768 * 1024;
constexpr size_t WS_WGU = 4 * MiB;
constexpr size_t WS_WD = 48 * MiB;
constexpr size_t WS_WQKV = 70 * MiB;
constexpr size_t WS_WO = 76 * MiB;
constexpr size_t WS_WF = 78 * MiB;
constexpr size_t WS_DFTS = 80 * MiB;
constexpr size_t WS_DFTC = 96 * MiB;
constexpr size_t WS_Y1 = 98 * MiB;
constexpr size_t WS_HB = 114 * MiB;
constexpr size_t WS_BIG = 186 * MiB;
constexpr size_t WS_Y1B = 402 * MiB;
constexpr size_t WS_END = 418 * MiB;
constexpr size_t WGU_SZ = (size_t)NGU * DM * 2, WD_SZ = (size_t)DM * DFF * 2;
constexpr size_t QK_STRIDE = (size_t)MC * DM;
constexpr int LDS_BYTES = 147456;

struct Args { const float* in[21]; float* out; unsigned char* ws; int ph_lo, ph_hi; };
typedef const __attribute__((address_space(4))) Args* KArgs;
#define KA() ({ KArgs _p = (KArgs)__builtin_amdgcn_kernarg_segment_ptr(); asm volatile("" : "+s"(_p)); _p; })
#define P_WS   (ka->ws)
#define P_OUT  (ka->out)
#define P_ADA  ((float*)(ka->ws + WS_ADA))
#define P_SCAL ((float*)(ka->ws + WS_SCAL))
#define P_ROPE ((f32x2*)(ka->ws + WS_ROPE))
#define P_WQKV ((bf16*)(ka->ws + WS_WQKV))
#define P_WO   ((bf16*)(ka->ws + WS_WO))
#define P_WF   ((bf16*)(ka->ws + WS_WF))
#define P_DFTS ((bf16*)(ka->ws + WS_DFTS))
#define P_DFTC ((bf16*)(ka->ws + WS_DFTC))
#define P_Y1   ((float*)(ka->ws + WS_Y1))
#define P_Y1B  ((float*)(ka->ws + WS_Y1B))
#define P_HB   ((bf16*)(ka->ws + WS_HB))
#define P_BIG  ((bf16*)(ka->ws + WS_BIG))

namespace pg8 {
#define PG8_LAS __attribute__((address_space(3)))
typedef unsigned short bf16_t;
constexpr int BM = 256, BK = 64, HALF = 128, HTB = HALF * BK * 2, STAGE_BYTES = 8 * HTB, NXCD = 8, WGM = 8;

__host__ __device__ __forceinline__ int lds_byte(int r, int c) { const int st = (r >> 4) * 2 + (c >> 5), rr = r & 15, cc = c & 31, ob = rr * 64 + cc * 2; return st * 1024 + (ob ^ (((ob >> 9) & 1) << 5)); }
__host__ __device__ __forceinline__ void stage_rc(int b, int& R, int& C) { const int st = b / 1024, sb = b % 1024, swz = sb ^ (((sb >> 9) & 1) << 5); R = (st >> 1) * 16 + swz / 64; C = (st & 1) * 32 + (swz % 64) / 2; }
__host__ __device__ __forceinline__ int perm32(int rho) { const int n = rho >> 4, i = rho & 15; return 8 * (i >> 2) + 4 * n + (i & 3); }

struct Unit { int pm, pn, g, kt0, ktn; };
struct Gemm { const bf16_t* A; const bf16_t* Bt; int K, lda, ldb; long long gstepA, gstepB; };

struct Order {
    int nM, nN, per, total, G, c, remapM, remapN, chan, swapg, ctxsplit;
    __device__ __forceinline__ void init(int nM_, int nN_, int nG_, int remapM_, int remapN_, int G_, int c_) { asm volatile("" : "+s"(c_), "+s"(G_));
        nM = nM_; nN = nN_; per = nM_ * nN_; total = per * nG_; remapM = remapM_; remapN = remapN_; G = G_; c = c_; chan = 0; swapg = 0; ctxsplit = 0; }
    __device__ __forceinline__ bool next(int i, Unit& u) const {
        const long L = (long)i * G + c; if (L >= total + ctxsplit) return false;
        u.kt0 = 0; u.ktn = 0;
        if (L >= total) {
            const int idx = (int)L - total, t = idx >> 1; u.g = idx & 1; u.pm = (t >> 2) * 9; u.pn = t & 3; u.kt0 = u.g * 22; u.ktn = 22; return true; }
        int wgid = (int)L; { const int q = total / NXCD, r = total % NXCD, xcd = wgid % NXCD, off = wgid / NXCD; wgid = (xcd < r ? xcd * (q + 1) : r * (q + 1) + (xcd - r) * q) + off; }
        u.g = wgid / per; const int w = wgid % per;
        const bool sw = swapg && u.g; const int nM = sw ? this->nN : this->nM, nN = sw ? this->nM : this->nN;
        const int nig = WGM * nN, gid = w / nig, fm = gid * WGM, gsz = (nM - fm) < WGM ? (nM - fm) : WGM;
        int pm = fm + ((w % nig) % gsz), pn = (w % nig) / gsz;
        if (remapM) pm = (pm >> 3) * 9 + 1 + (pm & 7);
        if (remapN) pn = (pn >> 3) * 9 + 1 + (pn & 7);
        if (chan) pm = ((pn % 9) - 1) >> 2;
        u.pm = pm; u.pn = pn; return true;
    }
    __device__ __forceinline__ void a_ready(const Unit&) const {}
    __device__ __forceinline__ void done(const Unit&) const {}
};

struct EpiBf16Split {
    static constexpr bool PERM = true, AFTER_DRAIN = false;
    bf16_t* O; int ldc; int split_cols; size_t split_stride;
    __device__ __forceinline__ void operator()(const f32x4 (&acc)[2][2][4][2], const Unit& u, int wr, int wc, int fr, int fq) const {
        const int row0 = u.pm * BM + wr * 64 + fr; int colt = u.pn * BM; bf16_t* base = O;
        { const int t = colt / split_cols; base += (size_t)t * split_stride; colt -= t * split_cols; }
        const int col0 = colt + wc * 32 + 8 * fq;
#pragma unroll
        for (int ai = 0; ai < 2; ++ai)
#pragma unroll
            for (int m = 0; m < 4; ++m) { bf16_t* rowp = base + (size_t)(row0 + ai * HALF + m * 16) * ldc + col0;
#pragma unroll
                for (int bj = 0; bj < 2; ++bj) { const f32x4 v0 = acc[ai][bj][m][0], v1 = acc[ai][bj][m][1];
                    u32x4 w; w.x = pk2(v0[0], v0[1]); w.y = pk2(v0[2], v0[3]); w.z = pk2(v1[0], v1[1]); w.w = pk2(v1[2], v1[3]);
                    *(u32x4*)(rowp + bj * HALF) = w; } }
    }
};
struct EpiQKV {
    static constexpr bool PERM = true, AFTER_DRAIN = false;
    int call;
    __device__ __forceinline__ void operator()(const f32x4 (&acc)[2][2][4][2], const Unit& u, int wr, int wc, int fr, int fq) const {
        asm volatile("" : "+v"(fr), "+v"(fq));
        KArgs ka = KA();
        if (call == 2 && u.g == 1) {
            const int row0 = u.pm * BM + wr * 64 + fr; int colt = u.pn * BM; const int t = colt / TOK; colt -= t * TOK;
            bf16_t* base = P_BIG + 2 * QK_STRIDE + (size_t)t * 1024 * TOK; const int col0 = colt + wc * 32 + 8 * fq;
#pragma unroll
            for (int ai = 0; ai < 2; ++ai)
#pragma unroll
                for (int m = 0; m < 4; ++m) { bf16_t* rowp = base + (size_t)(row0 + ai * HALF + m * 16) * TOK + col0;
#pragma unroll
                    for (int bj = 0; bj < 2; ++bj) { const f32x4 v0 = acc[ai][bj][m][0], v1 = acc[ai][bj][m][1];
                        u32x4 w; w.x = pk2(v0[0], v0[1]); w.y = pk2(v0[2], v0[3]); w.z = pk2(v1[0], v1[1]); w.w = pk2(v1[2], v1[3]);
                        *(u32x4*)(rowp + bj * HALF) = w; } }
            return;
        }
        const bool isK = (call == 2);
        const int jt = u.pm % 9;
        bf16_t* base = P_BIG + (isK ? QK_STRIDE : 0) + (size_t)(u.pm * BM) * DM + (u.pn * 4 + wc) * 64;
        const float* gn = isK ? ka->in[14] : ka->in[13];
        float cf[2][4];
#pragma unroll
        for (int n = 0; n < 2; ++n)
#pragma unroll
            for (int e = 0; e < 4; ++e) cf[n][e] = __builtin_amdgcn_exp2f(-(float)(8 * (fq & 1) + 4 * n + e) * 0.830482023722f) * 0.159154943092f;
        f32x4 gv[2][2];
#pragma unroll
        for (int bj = 0; bj < 2; ++bj)
#pragma unroll
            for (int n = 0; n < 2; ++n) gv[bj][n] = *(const f32x4*)(gn + bj * 32 + 8 * fq + 4 * n);
        const bool hi = fq >= 2;
#pragma unroll
        for (int ai = 0; ai < 2; ++ai)
#pragma unroll
            for (int m = 0; m < 4; ++m) {
                const int rl = ai * HALF + wr * 64 + m * 16 + fr;
                float ss = 0.f;
#pragma unroll
                for (int bj = 0; bj < 2; ++bj)
#pragma unroll
                    for (int n = 0; n < 2; ++n) { const f32x4 a = acc[ai][bj][m][n]; ss += (a.x * a.x + a.y * a.y) + (a.z * a.z + a.w * a.w); }
                ss += shx<16>(ss); ss = add_x32(ss);
                const float rstd = rsqrtf(ss * (1.f / 64.f) + EPS);
                f32x4 v[2][2];
#pragma unroll
                for (int bj = 0; bj < 2; ++bj)
#pragma unroll
                    for (int n = 0; n < 2; ++n) v[bj][n] = acc[ai][bj][m][n] * rstd * gv[bj][n];
                if (jt > 0) {
                    const int pos = (jt - 1) * 256 + rl;
#pragma unroll
                    for (int bj = 0; bj < 2; ++bj) { const float apos = (float)(bj ? (pos & 63) : (pos >> 6));
#pragma unroll
                        for (int n = 0; n < 2; ++n) {
                            f32x4 pv, cs, sn;
#pragma unroll
                            for (int e = 0; e < 4; ++e) { const float xr = __builtin_amdgcn_fractf(apos * cf[n][e]); sn[e] = __builtin_amdgcn_sinf(xr); cs[e] = __builtin_amdgcn_cosf(xr); }
#pragma unroll
                            for (int e = 0; e < 4; ++e) { float pa = v[bj][n][e], pb = pa;
                                asm volatile("s_nop 1\n\tv_permlane32_swap_b32 %0, %1" : "+v"(pa), "+v"(pb)); pv[e] = hi ? pa : pb; }
                            v[bj][n] = hi ? (v[bj][n] * cs + pv * sn) : (v[bj][n] * cs - pv * sn); } }
                }
                if (!isK) {
#pragma unroll
                    for (int bj = 0; bj < 2; ++bj)
#pragma unroll
                        for (int n = 0; n < 2; ++n) v[bj][n] = v[bj][n] * QSCALE;
                }
                bf16_t* rowp = base + (size_t)rl * DM + 8 * fq;
#pragma unroll
                for (int bj = 0; bj < 2; ++bj) { u32x4 w; w.x = pk2(v[bj][0][0], v[bj][0][1]); w.y = pk2(v[bj][0][2], v[bj][0][3]); w.z = pk2(v[bj][1][0], v[bj][1][1]); w.w = pk2(v[bj][1][2], v[bj][1][3]);
                    *(u32x4*)(rowp + bj * 32) = w; }
            }
    }
};
struct EpiSwiglu {
    static constexpr bool PERM = true, AFTER_DRAIN = false;
    bf16_t* O;
    __device__ __forceinline__ void operator()(const f32x4 (&acc)[2][2][4][2], const Unit& u, int wr, int wc, int fr, int fq) const {
        const int row0 = u.pm * BM + wr * 64 + fr, col0 = u.pn * HALF + wc * 32 + 8 * fq;
#pragma unroll
        for (int ai = 0; ai < 2; ++ai)
#pragma unroll
            for (int m = 0; m < 4; ++m) { bf16_t* rowp = O + (size_t)(row0 + ai * HALF + m * 16) * 2816 + col0;
                float v[8];
#pragma unroll
                for (int n = 0; n < 2; ++n)
#pragma unroll
                    for (int j = 0; j < 4; ++j) { const float g = acc[ai][0][m][n][j], uu = acc[ai][1][m][n][j];
                        v[4 * n + j] = g * uu * __builtin_amdgcn_rcpf(1.0f + __builtin_amdgcn_exp2f(-g)); }
                u32x4 w; w.x = pk2(v[0], v[1]); w.y = pk2(v[2], v[3]); w.z = pk2(v[4], v[5]); w.w = pk2(v[6], v[7]);
                *(u32x4*)rowp = w; }
    }
};
struct EpiGateRes {
    static constexpr bool PERM = false, AFTER_DRAIN = false;
    int first; int layer; int kg; float coef;
    __device__ __forceinline__ void operator()(const f32x4 (&acc)[2][2][4][2], const Unit& u, int wr, int wc, int fr, int fq) const {
        KArgs ka = KA();
        const int b = u.pm / 9, j = u.pm % 9; const float* rb; float* ob; int s;
        const bool nores = u.ktn && u.g;
        if (j == 0) { const size_t off = (size_t)b * 256 * 1024; rb = ka->in[2] + off; ob = (nores ? P_Y1B : P_Y1) + off; s = 16; }
        else { const size_t off = ((size_t)b * 2048 + (size_t)(j - 1) * 256) * 1024; rb = (first ? ka->in[0] : (const float*)P_OUT) + off; ob = P_OUT + off; s = b; }
        const float* gate = P_ADA + (size_t)layer * 17 * NMOD + (size_t)(s * 9 + kg) * 1024;
        const int row0 = wr * 64 + fr, col0 = u.pn * BM + wc * 32 + 4 * fq;
        f32x4 gv[2][2];
#pragma unroll
        for (int bj = 0; bj < 2; ++bj)
#pragma unroll
            for (int n = 0; n < 2; ++n) gv[bj][n] = *(const f32x4*)(gate + col0 + bj * HALF + n * 16) * coef;
        constexpr int NB_ = 4;
#pragma unroll
        for (int ai = 0; ai < 2; ++ai)
#pragma unroll
            for (int m0 = 0; m0 < 4; m0 += NB_) {
                f32x4 r[NB_][2][2];
#pragma unroll
                for (int mm = 0; mm < NB_; ++mm) { const size_t roff = (size_t)(row0 + ai * HALF + (m0 + mm) * 16) * 1024 + col0;
#pragma unroll
                    for (int bj = 0; bj < 2; ++bj)
#pragma unroll
                        for (int n = 0; n < 2; ++n) { r[mm][bj][n] = (f32x4){0.f, 0.f, 0.f, 0.f}; if (!nores) r[mm][bj][n] = *(const f32x4*)(rb + roff + bj * HALF + n * 16); } }
#pragma unroll
                for (int mm = 0; mm < NB_; ++mm) { const size_t roff = (size_t)(row0 + ai * HALF + (m0 + mm) * 16) * 1024 + col0;
#pragma unroll
                    for (int bj = 0; bj < 2; ++bj)
#pragma unroll
                        for (int n = 0; n < 2; ++n) *(f32x4*)(ob + roff + bj * HALF + n * 16) = r[mm][bj][n] + gv[bj][n] * acc[ai][bj][m0 + mm][n]; } }
    }
};
struct EpiChan {
    static constexpr bool PERM = true, AFTER_DRAIN = false;
    bf16_t* XT;
    __device__ __forceinline__ void operator()(const f32x4 (&acc)[2][2][4][2], const Unit& u, int wr, int wc, int fr, int fq) const {
        const int b = u.pn / 9, jt = u.pn % 9 - 1;
        bf16_t* base = XT + (size_t)(b * 1024 + u.g * 256) * 2048 + jt * 256;
        const int row0 = wr * 64 + fr, col0 = wc * 32 + 8 * fq;
#pragma unroll
        for (int ai = 0; ai < 2; ++ai)
#pragma unroll
            for (int m = 0; m < 4; ++m) { bf16_t* rowp = base + (size_t)(row0 + ai * HALF + m * 16) * 2048 + col0;
#pragma unroll
                for (int bj = 0; bj < 2; ++bj) { const f32x4 v0 = acc[ai][bj][m][0], v1 = acc[ai][bj][m][1];
                    u32x4 w; w.x = pk2(v0[0], v0[1]); w.y = pk2(v0[2], v0[3]); w.z = pk2(v1[0], v1[1]); w.w = pk2(v1[2], v1[3]);
                    *(u32x4*)(rowp + bj * HALF) = w; } }
    }
};
struct EpiSeq {
    static constexpr bool PERM = true, AFTER_DRAIN = false;
    bf16_t* O; const float* T;
    __device__ __forceinline__ void operator()(const f32x4 (&acc)[2][2][4][2], const Unit& u, int wr, int wc, int fr, int fq) const {
        const int row0 = u.pm * BM + wr * 64 + fr; const int colt = u.pn * BM; const int b = colt >> 10;
        bf16_t* base = O + (size_t)b * 2304 * 1024;
        const int col0 = (colt & 1023) + wc * 32 + 8 * fq;
        const float sg = (fr & 1) ? -1.0f : 1.0f;
        f32x4 tv[2][2];
#pragma unroll
        for (int bj = 0; bj < 2; ++bj)
#pragma unroll
            for (int n = 0; n < 2; ++n) tv[bj][n] = *(const f32x4*)(T + colt + wc * 32 + 8 * fq + bj * HALF + 4 * n) * sg;
#pragma unroll
        for (int ai = 0; ai < 2; ++ai)
#pragma unroll
            for (int m = 0; m < 4; ++m) { bf16_t* rowp = base + (size_t)(row0 + ai * HALF + m * 16) * 1024 + col0;
#pragma unroll
                for (int bj = 0; bj < 2; ++bj) { const f32x4 v0 = acc[ai][bj][m][0] + tv[bj][0], v1 = acc[ai][bj][m][1] + tv[bj][1];
                    u32x4 w; w.x = pk2(v0[0], v0[1]); w.y = pk2(v0[2], v0[3]); w.z = pk2(v1[0], v1[1]); w.w = pk2(v1[2], v1[3]);
                    *(u32x4*)(rowp + bj * HALF) = w; } }
    }
};

template <class Epi, class Sched, bool ALIGN_EPI = true>
__device__ __forceinline__ void gemm_phase(PG8_LAS unsigned char* lds, const Gemm g, const Sched& S, const Epi& E, int wv) {
    const int tid = wv * 64 + lane_id_v();
    const int wid = __builtin_amdgcn_readfirstlane(tid >> 6), lane = tid & 63, wr = wid >> 2, wc = wid & 3, fr = lane & 15, fq = lane >> 4;
    int K = g.K, lda = g.lda, ldb = g.ldb; asm volatile("" : "+s"(K), "+s"(lda), "+s"(ldb));
    const int ntK = K / BK;
    unsigned voffA[2], voffB[2];
#pragma unroll
    for (int i = 0; i < 2; ++i) { int R, C; stage_rc(tid * 16 + i * 8192, R, C); const int Rb = Epi::PERM ? ((R & ~31) + perm32(R & 31)) : R;
        voffA[i] = (unsigned)(R * lda + C) * 2u; voffB[i] = (unsigned)(Rb * ldb + C) * 2u; }
    const size_t kstep = (size_t)(BK * 2);
    const size_t hstepA = (size_t)HALF * lda * 2, hstepB = (size_t)HALF * ldb * 2;
    const size_t tstepA = 2 * hstepA, tstepB = 2 * hstepB;
    const unsigned ldsw = (unsigned)wid * 1024u;
    const int aoff = lds_byte(wr * 64 + fr, fq * 8), boff = lds_byte(wc * 32 + fr, fq * 8);
#define PG8_SA(b, h) (((b) * 2 + (h)) * HTB)
#define PG8_SB(b, h) ((4 + (b) * 2 + (h)) * HTB)
#define PG8_STAGE(bufoff, gbase, voff) do { _Pragma("unroll") for (int _i = 0; _i < 2; ++_i) \
        __builtin_amdgcn_global_load_lds((const unsigned*)((const char*)(gbase) + (voff)[_i]), (PG8_LAS unsigned*)(lds + (bufoff) + ldsw + _i * 8192), 16, 0, 0); } while (0)
#define PG8_LDA(dst, b, h) do { _Pragma("unroll") for (int m = 0; m < 4; ++m) _Pragma("unroll") for (int k = 0; k < 2; ++k) dst[m][k] = *(const PG8_LAS bf16x8*)(lds + PG8_SA(b, h) + aoff + m * 2048 + k * 1024); } while (0)
#define PG8_LDB(dst, b, h) do { _Pragma("unroll") for (int n = 0; n < 2; ++n) _Pragma("unroll") for (int k = 0; k < 2; ++k) dst[n][k] = *(const PG8_LAS bf16x8*)(lds + PG8_SB(b, h) + boff + n * 2048 + k * 1024); } while (0)
#define PG8_MMA(ai, bj, At, Bt) do { __builtin_amdgcn_s_setprio(1); _Pragma("unroll") for (int m = 0; m < 4; ++m) _Pragma("unroll") for (int n = 0; n < 2; ++n) _Pragma("unroll") for (int k = 0; k < 2; ++k) \
        acc[ai][bj][m][n] = __builtin_amdgcn_mfma_f32_16x16x32_bf16(Bt[n][k], At[m][k], acc[ai][bj][m][n], 0, 0, 0); __builtin_amdgcn_s_setprio(0); } while (0)
#define PG8_WAIT_V(n) asm volatile("s_waitcnt vmcnt(" #n ")" ::: "memory")
#define PG8_WAIT_L(n) asm volatile("s_waitcnt lgkmcnt(" #n ")" ::: "memory")
#define PG8_BAR __builtin_amdgcn_s_barrier()
#define PG8_SCHED __builtin_amdgcn_sched_barrier(0)
    Unit cur, nxt; int ui = 0;
    if (!S.next(0, cur)) return;
    f32x4 acc[2][2][4][2];
#pragma unroll
    for (int a = 0; a < 2; ++a)
#pragma unroll
        for (int b = 0; b < 2; ++b)
#pragma unroll
            for (int m = 0; m < 4; ++m)
#pragma unroll
                for (int n = 0; n < 2; ++n) acc[a][b][m][n] = (f32x4){0.f, 0.f, 0.f, 0.f};
    bf16x8 At[4][2], B0[2][2], B1[2][2];
    const char* cA = (const char*)g.A + (size_t)cur.pm * tstepA + (long long)cur.g * g.gstepA + (size_t)cur.kt0 * (BK * 2); const char* cB = (const char*)g.Bt + (size_t)cur.pn * tstepB + (long long)cur.g * g.gstepB + (size_t)cur.kt0 * (BK * 2);
    S.a_ready(cur);
    PG8_STAGE(PG8_SB(0, 0), cB, voffB); PG8_STAGE(PG8_SB(0, 1), cB + hstepB, voffB); PG8_STAGE(PG8_SA(0, 0), cA, voffA); PG8_STAGE(PG8_SA(0, 1), cA + hstepA, voffA);
    if (wr == 1) PG8_BAR;
    PG8_WAIT_V(2); PG8_BAR;
    PG8_STAGE(PG8_SB(1, 0), cB + kstep, voffB); PG8_STAGE(PG8_SA(1, 0), cA + kstep, voffA); PG8_STAGE(PG8_SB(1, 1), cB + hstepB + kstep, voffB);
    PG8_WAIT_V(6); PG8_BAR;
    for (;;) {
        const bool has_next = S.next(ui + 1, nxt);
        const char* nA = has_next ? (const char*)g.A + (size_t)nxt.pm * tstepA + (long long)nxt.g * g.gstepA + (size_t)nxt.kt0 * (BK * 2) : cA; const char* nB = has_next ? (const char*)g.Bt + (size_t)nxt.pn * tstepB + (long long)nxt.g * g.gstepB + (size_t)nxt.kt0 * (BK * 2) : cB;
        const int nt = cur.ktn ? cur.ktn : ntK;
        for (int t = 0; t < nt; t += 2) {
            const bool last = (t == nt - 2);
            const char* a1 = cA + (size_t)(t + 1) * kstep;
            const char* a2 = last ? nA : cA + (size_t)(t + 2) * kstep; const char* b2 = last ? nB : cB + (size_t)(t + 2) * kstep;
            const char* a3 = a2 + kstep; const char* b3 = b2 + kstep;
            if (last && has_next) S.a_ready(nxt);
            PG8_LDB(B0, 0, 0); PG8_LDB(B1, 0, 1); PG8_SCHED; PG8_LDA(At, 0, 0); PG8_STAGE(PG8_SA(1, 1), a1 + hstepA, voffA);
            PG8_WAIT_V(8); PG8_WAIT_L(0); PG8_BAR; PG8_MMA(0, 0, At, B0); PG8_MMA(0, 1, At, B1); PG8_BAR; PG8_SCHED;
            PG8_LDA(At, 0, 1); PG8_STAGE(PG8_SB(0, 0), b2, voffB); PG8_STAGE(PG8_SB(0, 1), b2 + hstepB, voffB); PG8_STAGE(PG8_SA(0, 0), a2, voffA);
            PG8_WAIT_V(8); PG8_WAIT_L(0); PG8_BAR; PG8_MMA(1, 0, At, B0); PG8_MMA(1, 1, At, B1); PG8_BAR; PG8_SCHED;
            PG8_LDB(B0, 1, 0); PG8_LDB(B1, 1, 1); PG8_SCHED; PG8_LDA(At, 1, 0); PG8_STAGE(PG8_SA(0, 1), a2 + hstepA, voffA);
            PG8_WAIT_V(8); PG8_WAIT_L(0); PG8_BAR; PG8_MMA(0, 0, At, B0); PG8_MMA(0, 1, At, B1); PG8_BAR; PG8_SCHED;
            PG8_LDA(At, 1, 1); PG8_STAGE(PG8_SB(1, 0), b3, voffB); PG8_STAGE(PG8_SB(1, 1), b3 + hstepB, voffB); PG8_STAGE(PG8_SA(1, 0), a3, voffA);
            PG8_WAIT_V(8); PG8_WAIT_L(0); PG8_BAR; PG8_MMA(1, 0, At, B0); PG8_MMA(1, 1, At, B1); PG8_BAR; PG8_SCHED;
        }
        if constexpr (ALIGN_EPI) { if (wr == 0) PG8_BAR; }
        E(acc, cur, wr, wc, fr, fq); S.done(cur);
        if (!has_next) break;
#pragma unroll
        for (int a = 0; a < 2; ++a)
#pragma unroll
            for (int b = 0; b < 2; ++b)
#pragma unroll
                for (int m = 0; m < 4; ++m)
#pragma unroll
                    for (int n = 0; n < 2; ++n) acc[a][b][m][n] = (f32x4){0.f, 0.f, 0.f, 0.f};
        cur = nxt; cA = nA; cB = nB; ++ui;
        if constexpr (ALIGN_EPI) { if (wr == 1) PG8_BAR; }
    }
    PG8_WAIT_V(0);
    if constexpr (!ALIGN_EPI) { if (wr == 0) PG8_BAR; }
    PG8_BAR;
#undef PG8_SA
#undef PG8_SB
#undef PG8_STAGE
#undef PG8_LDA
#undef PG8_LDB
#undef PG8_MMA
#undef PG8_WAIT_V
#undef PG8_WAIT_L
#undef PG8_BAR
#undef PG8_SCHED
}
}


#define XB_TMO      128
#define XB_XCNT(j)  (256  + 64 * (j))
#define XB_XSUB(j)  (1280 + 64 * (j))
#define XB_XGEN(j)  (2304 + 64 * (j))
#define XB_TOP      3328
#define XB_TOPGEN   3392
#define XCD_BAR_WORDS 3456
#define XB_SPIN_CAP (1u << 18)
__device__ __forceinline__ unsigned xb_ld(unsigned* p)              { return __hip_atomic_load(p, __ATOMIC_RELAXED, __HIP_MEMORY_SCOPE_AGENT); }
__device__ __forceinline__ unsigned xb_add(unsigned* p, unsigned v) { return __hip_atomic_fetch_add(p, v, __ATOMIC_RELAXED, __HIP_MEMORY_SCOPE_AGENT); }
__device__ __forceinline__ unsigned xb_xcc_id() { return (unsigned)__builtin_amdgcn_s_getreg((3 << 11) | 20) & 0xFu; }
#define XB_SPIN(cond, bar) do { unsigned _sp = 0; while (cond) { __builtin_amdgcn_s_sleep(1); \
    if ((++_sp & 255u) == 0u) { if (xb_ld(&(bar)[XB_TMO])) break; if (_sp > XB_SPIN_CAP) { atomicAdd(&(bar)[XB_TMO], 1u); break; } } } } while (0)
struct XcdBarrier { unsigned* bar; unsigned x; volatile LAS unsigned* st; };
__device__ __forceinline__ XcdBarrier xcd_barrier_post(unsigned* bar, volatile LAS unsigned* st, bool t0) {
    XcdBarrier b; b.bar = bar; b.x = xb_xcc_id(); b.st = st;
    if (t0) (void)xb_add(&bar[XB_XCNT(b.x)], 1u);
    return b;
}
__device__ __forceinline__ void xcd_barrier_complete(unsigned* bar, unsigned x, unsigned& nloc, unsigned& nx) {
    const unsigned G = gridDim.x * gridDim.y * gridDim.z;
    unsigned sum, cnt, mine, sp = 0u;
    for (;;) {
        sum = 0u; cnt = 0u; mine = 0u;
#pragma unroll
        for (unsigned j = 0; j < 16; ++j) { const unsigned c = xb_ld(&bar[XB_XCNT(j)]); sum += c; cnt += (c > 0u) ? 1u : 0u; mine = (j == x) ? c : mine; }
        if (sum == G) break;
        __builtin_amdgcn_s_sleep(1);
        if ((++sp & 255u) == 0u) { if (xb_ld(&bar[XB_TMO])) break; if (sp > XB_SPIN_CAP) { atomicAdd(&bar[XB_TMO], 1u); break; } }
    }
    nloc = mine > 0u ? mine : 1u; nx = cnt > 0u ? cnt : 1u;
}
__device__ __forceinline__ void xcd_barrier(const XcdBarrier& b, bool t0) {
    asm volatile("s_waitcnt vmcnt(0)" ::: "memory");
    __syncthreads();
    if (t0) {
        unsigned* bar = b.bar;
        __builtin_amdgcn_s_waitcnt(0);
        unsigned nloc = b.st[0], nx = b.st[1];
        if (nloc == 0u) { xcd_barrier_complete(bar, b.x, nloc, nx); b.st[0] = nloc; b.st[1] = nx; }
        const unsigned old = xb_add(&bar[XB_XSUB(b.x)], 1u);
        const unsigned gen = old / nloc;
        if (old + 1u == (gen + 1u) * nloc) {
            __builtin_amdgcn_fence(__ATOMIC_RELEASE, "agent");
            asm volatile("s_waitcnt vmcnt(0)" ::: "memory");
            const unsigned og = xb_add(&bar[XB_TOP], 1u);
            const unsigned tg = og / nx;
            if (og + 1u == (tg + 1u) * nx) xb_add(&bar[XB_TOPGEN], 1u);
            else XB_SPIN(xb_ld(&bar[XB_TOPGEN]) == tg, bar);
            __builtin_amdgcn_fence(__ATOMIC_ACQUIRE, "agent");
            xb_add(&bar[XB_XGEN(b.x)], 1u);
            asm volatile("s_waitcnt vmcnt(0)" ::: "memory");
        } else {
            XB_SPIN(xb_ld(&bar[XB_XGEN(b.x)]) == gen, bar);
            __builtin_amdgcn_fence(__ATOMIC_ACQUIRE, "agent");
            asm volatile("s_waitcnt vmcnt(0)" ::: "memory");
        }
    }
    __syncthreads();
}

__device__ __forceinline__ void transpose_item(const float* W, int K, int N, bf16* WT, bool gu, LAS float* scr, int item, int lane) {
    const int nblk = N / 64, kb = item / nblk, nb = item % nblk, k0 = 64 * kb, n0 = 64 * nb;
    int r0 = n0; bool qk = false;
    float wsc = 1.0f;
    if (gu) { const int jj = (n0 < DFF) ? n0 : n0 - DFF; r0 = (jj >> 7) * 256 + (jj & 127) + ((n0 < DFF) ? 0 : 128); wsc = (n0 < DFF) ? 1.44269504089f : 0.69314718056f; }
    if (N == 3072 && n0 < 2048) { qk = true; const int hc = n0 >> 6; r0 = (hc >> 2) * 256 + (hc & 3) * 32; }
    const int n4 = lane & 15, kr = lane >> 4;
    const float* wp = W + (size_t)(k0 + kr) * N + n0 + 4 * n4;
    f32x4 v[16];
#pragma unroll
    for (int i = 0; i < 16; ++i) v[i] = *(const f32x4*)(wp + (size_t)(4 * i) * N);
#pragma unroll
    for (int i = 0; i < 16; ++i) { LAS float* d = scr + (4 * i + kr) * 65 + 4 * n4; d[0] = v[i].x; d[1] = v[i].y; d[2] = v[i].z; d[3] = v[i].w; }
    asm volatile("s_waitcnt lgkmcnt(0)" ::: "memory");
    const int c = lane & 7;
#pragma unroll
    for (int j = 0; j < 8; ++j) { const int n = (lane >> 3) + 8 * j; const LAS float* q = scr + (8 * c) * 65 + n;
        u32x4 o; o.x = pk2(q[0 * 65] * wsc, q[1 * 65] * wsc); o.y = pk2(q[2 * 65] * wsc, q[3 * 65] * wsc); o.z = pk2(q[4 * 65] * wsc, q[5 * 65] * wsc); o.w = pk2(q[6 * 65] * wsc, q[7 * 65] * wsc);
        *(u32x4*)(WT + (size_t)(qk ? (r0 + (n >> 5) * 128 + (n & 31)) : (r0 + n)) * K + k0 + 8 * c) = o; }
    asm volatile("s_waitcnt lgkmcnt(0)" ::: "memory");
}


__device__ __forceinline__ void norm_phase(const float* xsrc, const float* ysrc, const float* ysrc2, const float* gvec, const float* ada, int kshift, bf16* hb, bool with_ctx, int vcu, int NGW, int wv) {
    const int tid = wv * 64 + lane_id_v(); asm volatile("" : "+s"(vcu), "+s"(NGW));
    const int lane = tid & 63, gw = vcu * 8 + __builtin_amdgcn_readfirstlane(tid >> 6);
    const int nrows = with_ctx ? MC : MX, rpw = (nrows + NGW - 1) / NGW, r0 = gw * rpw;
    int prev_s = -1; f32x4 gsv[4], shv[4], vn[4];
#define NORM_ROWPOS(i_, b_, j_) do { if (with_ctx) { b_ = (i_) / TOK; j_ = (i_) % TOK; } else { b_ = (i_) >> 11; j_ = 256 + ((i_) & 2047); } } while (0)
#define NORM_LOAD(i_, dst_) do { int b_, j_; NORM_ROWPOS(i_, b_, j_); \
        if (j_ < CTX) { const f32x4* p_ = (const f32x4*)(ysrc + ((size_t)b_ * CTX + j_) * DM) + lane; _Pragma("unroll") for (int q = 0; q < 4; ++q) dst_[q] = p_[64 * q]; \
            if (ysrc2) { const f32x4* p2_ = (const f32x4*)(ysrc2 + ((size_t)b_ * CTX + j_) * DM) + lane; _Pragma("unroll") for (int q = 0; q < 4; ++q) dst_[q] += p2_[64 * q]; } } \
        else { const f32x4* p_ = (const f32x4*)(xsrc + ((size_t)b_ * SEQ + (j_ - CTX)) * DM) + lane; _Pragma("unroll") for (int q = 0; q < 4; ++q) dst_[q] = p_[64 * q]; } } while (0)
    if (r0 < nrows) NORM_LOAD(r0, vn);
    for (int k = 0; k < rpw; ++k) {
        const int i = r0 + k; if (i >= nrows) break;
        f32x4 v[4];
#pragma unroll
        for (int q = 0; q < 4; ++q) v[q] = vn[q];
        if (k + 1 < rpw && i + 1 < nrows) NORM_LOAD(i + 1, vn);
        int b, j; NORM_ROWPOS(i, b, j);
        const int s = (j < CTX) ? 16 : b;
        if (s != prev_s) { prev_s = s;
            const f32x4* gp = (const f32x4*)gvec + lane; const f32x4* shp = (const f32x4*)(ada + (size_t)(s * 9 + kshift) * DM) + lane; const f32x4* scp = shp + DM / 4;
#pragma unroll
            for (int q = 0; q < 4; ++q) { gsv[q] = gp[64 * q] * (scp[64 * q] + 1.0f); shv[q] = shp[64 * q]; } }
        float ss = 0.f;
#pragma unroll
        for (int q = 0; q < 4; ++q) ss += (v[q].x * v[q].x + v[q].y * v[q].y) + (v[q].z * v[q].z + v[q].w * v[q].w);
        const float rstd = rsqrtf(wave_sum(ss) * (1.f / DM) + EPS);
        u32x2* o8 = (u32x2*)(hb + ((size_t)b * TOK + j) * DM) + lane;
#pragma unroll
        for (int q = 0; q < 4; ++q) { const f32x4 o = v[q] * rstd * gsv[q] + shv[q];
            u32x2 w; w.x = pk2(o.x, o.y); w.y = pk2(o.z, o.w); o8[64 * q] = w; }
    }
#undef NORM_LOAD
#undef NORM_ROWPOS
}

__device__ __forceinline__ void norm_fourier_phase(const float* xsrc, const float* gvec, const float* ada, bf16* hb, float* h1024, int vcu, int NGW, int wv) {
    const int tid = wv * 64 + lane_id_v(); asm volatile("" : "+s"(vcu), "+s"(NGW));
    const int lane = tid & 63, gw = vcu * 8 + __builtin_amdgcn_readfirstlane(tid >> 6);
    const int nit = NB * 1024, ipw = (nit + NGW - 1) / NGW, i0 = gw * ipw;
    int prev_b = -1; f32x4 gsv[4], shv[4], na[4], nb[4];
#define NF_LOAD(i_) do { const int b_ = (i_) >> 10, p_ = (i_) & 1023, p2_ = p_ ? (SEQ - p_) : (SEQ / 2); \
        const f32x4* xa_ = (const f32x4*)(xsrc + ((size_t)b_ * SEQ + p_) * DM) + lane; const f32x4* xb_ = (const f32x4*)(xsrc + ((size_t)b_ * SEQ + p2_) * DM) + lane; \
        _Pragma("unroll") for (int q = 0; q < 4; ++q) { na[q] = xa_[64 * q]; nb[q] = xb_[64 * q]; } } while (0)
    if (i0 < nit) NF_LOAD(i0);
    for (int k = 0; k < ipw; ++k) {
        const int i = i0 + k; if (i >= nit) break;
        const int b = i >> 10, p = i & 1023;
        f32x4 va[4], vb[4];
#pragma unroll
        for (int q = 0; q < 4; ++q) { va[q] = na[q]; vb[q] = nb[q]; }
        if (k + 1 < ipw && i + 1 < nit) NF_LOAD(i + 1);
        if (b != prev_b) { prev_b = b;
            const f32x4* gp = (const f32x4*)gvec + lane; const f32x4* shp = (const f32x4*)(ada + (size_t)(b * 9 + 3) * DM) + lane; const f32x4* scp = shp + DM / 4;
#pragma unroll
            for (int q = 0; q < 4; ++q) { gsv[q] = gp[64 * q] * (scp[64 * q] + 1.0f); shv[q] = shp[64 * q]; } }
        float sa = 0.f, sb = 0.f;
#pragma unroll
        for (int q = 0; q < 4; ++q) { sa += (va[q].x * va[q].x + va[q].y * va[q].y) + (va[q].z * va[q].z + va[q].w * va[q].w); sb += (vb[q].x * vb[q].x + vb[q].y * vb[q].y) + (vb[q].z * vb[q].z + vb[q].w * vb[q].w); }
        const float ra = rsqrtf(wave_sum(sa) * (1.f / DM) + EPS), rb = rsqrtf(wave_sum(sb) * (1.f / DM) + EPS);
        u32x2* oe = (u32x2*)(hb + ((size_t)b * TOK + CTX + p) * DM) + lane; u32x2* oo = (u32x2*)(hb + ((size_t)b * TOK + CTX + 1024 + p) * DM) + lane;
        f32x4* hs = (f32x4*)(h1024 + (size_t)b * DM) + lane;
#pragma unroll
        for (int q = 0; q < 4; ++q) { const f32x4 ha = va[q] * ra * gsv[q] + shv[q], hbv = vb[q] * rb * gsv[q] + shv[q];
            f32x4 e, o;
            if (p) { e = ha + hbv; o = ha - hbv; } else { e = ha; o = (f32x4){0.f, 0.f, 0.f, 0.f}; hs[64 * q] = hbv; }
            u32x2 we, wo; we.x = pk2(e.x, e.y); we.y = pk2(e.z, e.w); wo.x = pk2(o.x, o.y); wo.y = pk2(o.z, o.w);
            oe[64 * q] = we; oo[64 * q] = wo; }
    }
#undef NF_LOAD
}

__device__ __forceinline__ void ada_phase(LAS unsigned char* lds, const float* c, const float* c_ctx, const float* w_mod, const float* b_mod, float* ada, int G, int bid, int wv) {
    const int tid = wv * 64 + lane_id_v();
    LAS float* sc = (LAS float*)lds;
    LAS float* red = (LAS float*)(lds + 17 * 1024 * 4);
    {
        float cv[34];
#pragma unroll
        for (int q = 0; q < 34; ++q) { const int i = tid + 512 * q, s = i >> 10, k = i & 1023; cv[q] = (s < 16) ? c[s * 1024 + k] : c_ctx[k]; }
#pragma unroll
        for (int q = 0; q < 34; ++q) sc[tid + 512 * q] = cv[q] / (1.0f + __expf(-cv[q]));
    }
    __syncthreads();
    const int lane = tid & 63, w = tid >> 6, n4 = lane & 15, kr = lane >> 4;
    for (int item = bid; item < 288; item += G) {
        const int layer = item / 144, c0 = (item % 144) * 64;
        const float* W = w_mod + (size_t)layer * 1024 * NMOD + (size_t)(w * 128 + kr) * NMOD + c0 + 4 * n4;
        const LAS float* scp = sc + w * 128 + kr;
        f32x4 acc[17];
#pragma unroll
        for (int s = 0; s < 17; ++s) acc[s] = (f32x4){0.f, 0.f, 0.f, 0.f};
        for (int st0 = 0; st0 < 32; st0 += 8) {
            f32x4 wv[8];
#pragma unroll
            for (int u = 0; u < 8; ++u) wv[u] = *(const f32x4*)(W + (size_t)(4 * (st0 + u)) * NMOD);
#pragma unroll
            for (int u = 0; u < 8; ++u) {
#pragma unroll
                for (int s = 0; s < 17; ++s) acc[s] += wv[u] * scp[s * 1024 + 4 * (st0 + u)];
                __builtin_amdgcn_sched_barrier(0); } }
#pragma unroll
        for (int s = 0; s < 17; ++s)
#pragma unroll
            for (int e = 0; e < 4; ++e) { float v = acc[s][e]; v += __shfl_xor(v, 16); v += __shfl_xor(v, 32); if (lane < 16) red[(w * 17 + s) * 64 + 4 * n4 + e] = v; }
        __syncthreads();
        for (int o = tid; o < 17 * 64; o += 512) { const int s = o >> 6, cc = o & 63; float sum = 0.f;
#pragma unroll
            for (int q = 0; q < 8; ++q) sum += red[(q * 17 + s) * 64 + cc];
            ada[(size_t)(layer * 17 + s) * NMOD + c0 + cc] = sum + b_mod[layer * NMOD + c0 + cc]; }
        __syncthreads();
    }
}

__device__ __forceinline__ void qknorm_phase(bf16* Qr, bf16* Kr, const float* qg, const float* kg, const f32x2* rope, int vcu, int NGW, int wv) {
    const int tid = wv * 64 + lane_id_v(); asm volatile("" : "+s"(vcu), "+s"(NGW));
    const int lane = tid & 63, gw = vcu * 8 + __builtin_amdgcn_readfirstlane(tid >> 6);
    for (int it = gw; it < MC * 2; it += NGW) {
        const int r = it >> 1, which = it & 1, b = r / TOK, j = r % TOK;
        if (j < CTX && which == 0) continue;
        bf16* p = (which ? Kr : Qr) + (size_t)r * DM + lane * 16;
        const u32x4 w0 = *(const u32x4*)p, w1 = *(const u32x4*)(p + 8);
        float v[16];
        v[0] = bf_lo(w0.x); v[1] = bf_hi(w0.x); v[2] = bf_lo(w0.y); v[3] = bf_hi(w0.y); v[4] = bf_lo(w0.z); v[5] = bf_hi(w0.z); v[6] = bf_lo(w0.w); v[7] = bf_hi(w0.w);
        v[8] = bf_lo(w1.x); v[9] = bf_hi(w1.x); v[10] = bf_lo(w1.y); v[11] = bf_hi(w1.y); v[12] = bf_lo(w1.z); v[13] = bf_hi(w1.z); v[14] = bf_lo(w1.w); v[15] = bf_hi(w1.w);
        float ss = 0.f;
#pragma unroll
        for (int i = 0; i < 16; ++i) ss += v[i] * v[i];
        ss += shx<1>(ss); ss += shx<2>(ss);
        const float rstd = rsqrtf(ss * (1.f / 64.f) + EPS);
        const float* gn = (which ? kg : qg) + (lane & 3) * 16;
#pragma unroll
        for (int i = 0; i < 16; ++i) v[i] = v[i] * rstd * gn[i];
        if (j >= CTX) {
            const int pos = j - CTX, axis = (lane >> 1) & 1, half = lane & 1;
            const f32x2* cs = rope + ((size_t)pos * 2 + axis) * 16;
#pragma unroll
            for (int i = 0; i < 16; ++i) { const float pv = shx<1>(v[i]); const f32x2 t = cs[i];
                v[i] = half ? (v[i] * t.x + pv * t.y) : (v[i] * t.x - pv * t.y); }
        }
        if (which == 0) {
#pragma unroll
            for (int i = 0; i < 16; ++i) v[i] *= QSCALE;
        }
        u32x4 o0, o1;
        o0.x = pk2(v[0], v[1]); o0.y = pk2(v[2], v[3]); o0.z = pk2(v[4], v[5]); o0.w = pk2(v[6], v[7]);
        o1.x = pk2(v[8], v[9]); o1.y = pk2(v[10], v[11]); o1.z = pk2(v[12], v[13]); o1.w = pk2(v[14], v[15]);
        *(u32x4*)p = o0; *(u32x4*)(p + 8) = o1;
    }
}

constexpr int AT_ROW = 144, AT_SLOT = 128 * AT_ROW  , AT_K = 0, AT_V = 3 * AT_SLOT  , AT_X = 0, AT_OUT = 5 * AT_SLOT  , AT_OROW = 272;
__device__ __forceinline__ int crow(int i, int h) { return (i & 3) + 8 * (i >> 2) + 4 * h; }
#define MFMA32(a, b, c) __builtin_amdgcn_mfma_f32_32x32x16_bf16((a), (b), (c), 0, 0, 0)
__device__ __forceinline__ void attn_phase(LAS unsigned char* lds, const bf16* Q, const bf16* Kt, const bf16* VT, bf16* O, float out_scale, int G, int bid, int wv) {
    const int tid = wv * 64 + lane_id_v();
    const int lane = tid & 63, r = lane & 31, h = lane >> 5, wid = __builtin_amdgcn_readfirstlane(tid >> 6), c = wid & 1, qg = wid >> 1;
    asm volatile("" : "+s"(bid), "+s"(G));
    const int vcu = (G % 8 == 0) ? (bid % 8) * (G / 8) + bid / 8 : bid;
    const int srow2 = (tid & 255) >> 3, spart = tid & 7; const bool lead = wid < 4;
    const int rsw = (r & 19) | ((r & 4) << 1) | ((r & 8) >> 1);
    const int koff = AT_K + (c * 64 + rsw) * AT_ROW + h * 16, voff = AT_V + r * AT_ROW + h * 16;
    const int sdst = srow2 * AT_ROW + spart * 16;
    constexpr int NT = TOK / 64;
    f32x16 zero16;
#pragma unroll
    for (int i = 0; i < 16; ++i) zero16[i] = 0.f;
#define AT_BAR() do { asm volatile("s_waitcnt lgkmcnt(0)" ::: "memory"); __builtin_amdgcn_s_barrier(); asm volatile("" ::: "memory"); } while (0)
    const size_t go1 = lead ? (size_t)32 * DM : (size_t)32 * TOK, go2 = lead ? (size_t)64 : (size_t)64 * TOK, go3 = go1 + go2;
    const int gstep = lead ? 64 * DM : 64;
    bf16x8 pq[4]; u32x4 pa[4], pb[4];
#define AT_PREFETCH(U) do { const int bh_ = (U) >> 4, qb_ = (U) & 15, b_ = bh_ >> 3, hh_ = bh_ & 7, q0_ = qb_ * 128; \
        const bf16* qp_ = Q + ((size_t)b_ * TOK + CTX + q0_ + qg * 32 + r) * DM + hh_ * 128 + c * 64 + h * 8; \
        _Pragma("unroll") for (int d0 = 0; d0 < 4; ++d0) pq[d0] = *(const bf16x8*)(qp_ + d0 * 16); \
        const bf16* g_ = lead ? Kt + ((size_t)b_ * TOK + srow2) * DM + hh_ * 128 + spart * 8 : VT + ((size_t)(b_ * 1024 + hh_ * 128 + srow2)) * TOK + spart * 8; \
        pa[0] = *(const u32x4*)(g_); pa[1] = *(const u32x4*)(g_ + go1); pa[2] = *(const u32x4*)(g_ + go2); pa[3] = *(const u32x4*)(g_ + go3); \
        { const bf16* g1_ = g_ + gstep; pb[0] = *(const u32x4*)(g1_); pb[1] = *(const u32x4*)(g1_ + go1); pb[2] = *(const u32x4*)(g1_ + go2); pb[3] = *(const u32x4*)(g1_ + go3); } } while (0)
    { const int u0 = vcu < NB * 8 * 16 ? vcu : NB * 8 * 16 - 1; AT_PREFETCH(u0); }
    for (int unit = vcu; unit < NB * 8 * 16; unit += G) {
        const int bh = unit >> 4, qb = unit & 15, b = bh >> 3, hh = bh & 7, q0 = qb * 128;
        bf16x8 qf[4];
#pragma unroll
        for (int d0 = 0; d0 < 4; ++d0) qf[d0] = pq[d0];
        const bf16* g0 = lead ? Kt + ((size_t)b * TOK + srow2) * DM + hh * 128 + spart * 8 : VT + ((size_t)(b * 1024 + hh * 128 + srow2)) * TOK + spart * 8;
        f32x16 o[4];
#pragma unroll
        for (int d = 0; d < 4; ++d)
#pragma unroll
            for (int i = 0; i < 16; ++i) o[d][i] = 0.f;
        float lsum0 = 0.f, lsum1 = 0.f;
        u32x4 st[4];
        {
            const int d0 = (lead ? AT_K : AT_V) + sdst;
            *(LAS u32x4*)(lds + d0) = pa[0]; *(LAS u32x4*)(lds + d0 + 32 * AT_ROW) = pa[1]; *(LAS u32x4*)(lds + d0 + 64 * AT_ROW) = pa[2]; *(LAS u32x4*)(lds + d0 + 96 * AT_ROW) = pa[3];
            if (lead) { const int d1 = AT_K + AT_SLOT + sdst;
                *(LAS u32x4*)(lds + d1) = pb[0]; *(LAS u32x4*)(lds + d1 + 32 * AT_ROW) = pb[1]; *(LAS u32x4*)(lds + d1 + 64 * AT_ROW) = pb[2]; *(LAS u32x4*)(lds + d1 + 96 * AT_ROW) = pb[3]; }
        }
        __syncthreads();
        f32x16 sc0, sc1, sn0, sn1;
        {
            sc0 = zero16; sc1 = zero16;
#pragma unroll
            for (int d0 = 0; d0 < 4; ++d0) { const bf16x8 k0 = *(const LAS bf16x8*)(lds + koff + d0 * 32), k1 = *(const LAS bf16x8*)(lds + koff + 32 * AT_ROW + d0 * 32);
                sc0 = MFMA32(k0, qf[d0], sc0); sc1 = MFMA32(k1, qf[d0], sc1); }
        }
        if (!lead) AT_BAR();
        int ks_next = AT_SLOT, ks_fill = 2 * AT_SLOT;
#define SEQ_MV __builtin_amdgcn_sched_group_barrier(0x100, 4, 0); _Pragma("unroll") for (int q = 0; q < 4; ++q) { __builtin_amdgcn_sched_group_barrier(0x8, 1, 0); __builtin_amdgcn_sched_group_barrier(0x100, 1, 0); __builtin_amdgcn_sched_group_barrier(0x402, 5, 0); } _Pragma("unroll") for (int q = 0; q < 4; ++q) { __builtin_amdgcn_sched_group_barrier(0x8, 1, 0); __builtin_amdgcn_sched_group_barrier(0x402, 5, 0); }
#define SEQ_M __builtin_amdgcn_sched_group_barrier(0x100, 4, 0); _Pragma("unroll") for (int q = 0; q < 4; ++q) { __builtin_amdgcn_sched_group_barrier(0x8, 1, 0); __builtin_amdgcn_sched_group_barrier(0x100, 1, 0); } __builtin_amdgcn_sched_group_barrier(0x8, 4, 0);
#define ATT_BODY(HAS_NEXT, C0, C1, N0, N1) do { \
            const int vs = (t & 1) * AT_SLOT; \
            if (HAS_NEXT) { const int tk = lead ? ((t + 2 < NT) ? t + 2 : NT - 1) : t + 1; const bf16* g = g0 + (size_t)tk * gstep; \
                st[0] = *(const u32x4*)(g); st[1] = *(const u32x4*)(g + go1); st[2] = *(const u32x4*)(g + go2); st[3] = *(const u32x4*)(g + go3); } \
            bf16x8 pf[2][2]; \
            {   \
                bf16x8 kf[2][4]; \
                if (HAS_NEXT) { _Pragma("unroll") for (int d0 = 0; d0 < 4; ++d0) { kf[0][d0] = *(const LAS bf16x8*)(lds + ks_next + koff + d0 * 32); kf[1][d0] = *(const LAS bf16x8*)(lds + ks_next + koff + 32 * AT_ROW + d0 * 32); } \
                    N0 = MFMA32(kf[0][0], qf[0], zero16); N1 = MFMA32(kf[1][0], qf[0], zero16); \
                    _Pragma("unroll") for (int d0 = 1; d0 < 4; ++d0) { N0 = MFMA32(kf[0][d0], qf[d0], N0); N1 = MFMA32(kf[1][d0], qf[d0], N1); } } \
                _Pragma("unroll") for (int i = 0; i < 16; i += 2) { C0[i] = __builtin_amdgcn_exp2f(C0[i]); C0[i + 1] = __builtin_amdgcn_exp2f(C0[i + 1]); lsum0 += C0[i]; lsum1 += C0[i + 1]; } \
                _Pragma("unroll") for (int sx = 0; sx < 2; ++sx) { u32x4 w; w.x = pk2(C0[8 * sx], C0[8 * sx + 1]); w.y = pk2(C0[8 * sx + 2], C0[8 * sx + 3]); w.z = pk2(C0[8 * sx + 4], C0[8 * sx + 5]); w.w = pk2(C0[8 * sx + 6], C0[8 * sx + 7]); pf[0][sx] = __builtin_bit_cast(bf16x8, w); } \
                if (HAS_NEXT) { SEQ_MV } \
            } \
            __builtin_amdgcn_sched_barrier(0); \
            AT_BAR(); \
            {   \
                bf16x8 vf[4][2]; \
                _Pragma("unroll") for (int sx = 0; sx < 2; ++sx) _Pragma("unroll") for (int dvb = 0; dvb < 4; ++dvb) vf[dvb][sx] = *(const LAS bf16x8*)(lds + vs + voff + dvb * 32 * AT_ROW + sx * 32); \
                _Pragma("unroll") for (int sx = 0; sx < 2; ++sx) _Pragma("unroll") for (int dvb = 0; dvb < 4; ++dvb) o[dvb] = MFMA32(vf[dvb][sx], pf[0][sx], o[dvb]); \
                _Pragma("unroll") for (int i = 0; i < 16; i += 2) { C1[i] = __builtin_amdgcn_exp2f(C1[i]); C1[i + 1] = __builtin_amdgcn_exp2f(C1[i + 1]); lsum0 += C1[i]; lsum1 += C1[i + 1]; } \
                _Pragma("unroll") for (int sx = 0; sx < 2; ++sx) { u32x4 w; w.x = pk2(C1[8 * sx], C1[8 * sx + 1]); w.y = pk2(C1[8 * sx + 2], C1[8 * sx + 3]); w.z = pk2(C1[8 * sx + 4], C1[8 * sx + 5]); w.w = pk2(C1[8 * sx + 6], C1[8 * sx + 7]); pf[1][sx] = __builtin_bit_cast(bf16x8, w); } \
                SEQ_MV \
            } \
            __builtin_amdgcn_sched_barrier(0); \
            {   \
                bf16x8 vf[4][2]; \
                _Pragma("unroll") for (int sx = 0; sx < 2; ++sx) _Pragma("unroll") for (int dvb = 0; dvb < 4; ++dvb) vf[dvb][sx] = *(const LAS bf16x8*)(lds + vs + voff + dvb * 32 * AT_ROW + 64 + sx * 32); \
                _Pragma("unroll") for (int sx = 0; sx < 2; ++sx) _Pragma("unroll") for (int dvb = 0; dvb < 4; ++dvb) o[dvb] = MFMA32(vf[dvb][sx], pf[1][sx], o[dvb]); \
                SEQ_M \
            } \
            if (HAS_NEXT) { const int dd = (lead ? ks_fill : AT_V + (AT_SLOT - vs)) + sdst; \
                *(LAS u32x4*)(lds + dd) = st[0]; *(LAS u32x4*)(lds + dd + 32 * AT_ROW) = st[1]; *(LAS u32x4*)(lds + dd + 64 * AT_ROW) = st[2]; *(LAS u32x4*)(lds + dd + 96 * AT_ROW) = st[3]; } \
            AT_BAR(); \
            if (HAS_NEXT) { const int tmp = ks_next; ks_next = ks_fill; ks_fill = (tmp == 0) ? 2 * AT_SLOT : tmp - AT_SLOT; } \
        } while (0)
        int t = 0;
        for (; t < NT - 2; t += 2) { ATT_BODY(true, sc0, sc1, sn0, sn1); ++t; ATT_BODY(true, sn0, sn1, sc0, sc1); --t; }
        ATT_BODY(true, sc0, sc1, sn0, sn1); ++t;
        ATT_BODY(false, sn0, sn1, sc0, sc1);
#undef ATT_BODY
#undef SEQ_MV
#undef SEQ_M
        if (lead) AT_BAR();
        { int un = unit + G; asm volatile("" : "+s"(un));
          un = un < NB * 8 * 16 ? un : NB * 8 * 16 - 1;
          AT_PREFETCH(un); }
        const float lsum = lsum0 + lsum1;
        KArgs ka = KA(); const float lam = P_SCAL[0]; const float* sub_g = ka->in[19];
        const float l = add_x32(lsum);
        LAS float* X = (LAS float*)(lds + AT_X);
        if (c == 1) { const float f = lam / l;
#pragma unroll
            for (int dvb = 0; dvb < 4; ++dvb)
#pragma unroll
                for (int i = 0; i < 16; ++i) X[(qg * 128 + dvb * 32 + crow(i, h)) * 32 + r] = o[dvb][i] * f; }
        AT_BAR();
        if (c == 0) { const float f = 1.0f / l; float ss = 0.f;
#pragma unroll
            for (int dvb = 0; dvb < 4; ++dvb)
#pragma unroll
                for (int i = 0; i < 16; ++i) { const float v = o[dvb][i] * f - X[(qg * 128 + dvb * 32 + crow(i, h)) * 32 + r]; o[dvb][i] = v; ss += v * v; }
            ss = add_x32(ss);
            const float rstd = rsqrtf(ss * (1.f / 128.f) + EPS) * out_scale;
#pragma unroll
            for (int dvb = 0; dvb < 4; ++dvb)
#pragma unroll
                for (int i4 = 0; i4 < 4; ++i4) { const int dv = dvb * 32 + 8 * i4 + 4 * h; const f32x4 sg = *(const f32x4*)(sub_g + dv);
                    u32x2 w; w.x = pk2(o[dvb][4 * i4] * rstd * sg.x, o[dvb][4 * i4 + 1] * rstd * sg.y); w.y = pk2(o[dvb][4 * i4 + 2] * rstd * sg.z, o[dvb][4 * i4 + 3] * rstd * sg.w);
                    *(LAS u32x2*)(lds + AT_OUT + (qg * 32 + r) * AT_OROW + dv * 2) = w; } }
        AT_BAR();
#pragma unroll
        for (int i = 0; i < 4; ++i) { const int ch = tid + 512 * i, row = ch >> 4, part = ch & 15;
            const u32x4 v = *(const LAS u32x4*)(lds + AT_OUT + row * AT_OROW + part * 16);
            *(u32x4*)(O + ((size_t)b * TOK + CTX + q0 + row) * DM + hh * 128 + part * 8) = v; }
    }
#undef AT_PREFETCH
    __syncthreads();
}

__global__ void __launch_bounds__(512, 2) fwd_kernel(Args args) {
    extern __shared__ __attribute__((aligned(16))) unsigned char lds_raw[];
    LAS unsigned char* lds = (LAS unsigned char*)lds_raw;
    cg::grid_group grid = cg::this_grid();
    const int G = gridDim.x, bid = blockIdx.x;
    const int wv = __builtin_amdgcn_readfirstlane(threadIdx.x >> 6);
    const int vcu = (G % 8 == 0) ? (bid % 8) * (G / 8) + bid / 8 : bid;
    const int NGW = G * 8;
    const int lo = args.ph_lo, hi = args.ph_hi;
    int ph = 0;
    volatile LAS unsigned* bst = (volatile LAS unsigned*)(lds + LDS_BYTES - 64);
    { const int tid = wv * 64 + lane_id_v(); if (tid < 2) bst[tid] = 0u; __syncthreads(); }
    if (lo < 0) grid.sync();
    unsigned xcc;
    { KArgs kb = KA(); xcc = xcd_barrier_post((unsigned*)kb->ws, bst, wv == 0 && lane_id_v() == 0).x; }
#ifdef TPROBE
    unsigned long long tp1 = __builtin_amdgcn_s_memrealtime(), tp2 = 0; int tpn = 0;
#define TP_MARK() do { ++tpn; if (tpn == TPROBE) tp1 = __builtin_amdgcn_s_memrealtime(); if (tpn == TPROBE + 1) tp2 = __builtin_amdgcn_s_memrealtime(); } while (0)
#else
#define TP_MARK() do {} while (0)
#endif
#ifndef REP_MASK
#define REP_MASK 0
#endif
#define NREP(k) (((REP_MASK >> (k)) & 1) ? 2 : 1)
#define RUN() (lo <= ph && ph < hi)
#define XBAR() do { KArgs kb = KA(); XcdBarrier xb_; xb_.bar = (unsigned*)kb->ws; xb_.x = xcc; xb_.st = bst; xcd_barrier(xb_, wv == 0 && lane_id_v() == 0); } while (0)
#define SEAM() do { if (lo <= ph && ph + 1 < hi) { XBAR(); if ((REP_MASK >> 6) & 1) { XBAR(); } } ++ph; TP_MARK(); } while (0)

    if (RUN()) for (int rep = 0; rep < NREP(0); ++rep) {
        if (rep) XBAR();
        KArgs ka = KA();
        for (int r2 = 0; r2 < NREP(8); ++r2) ada_phase(lds, ka->in[1], ka->in[3], ka->in[5], ka->in[6], P_ADA, G, bid, wv);
        const int tid = wv * 64 + lane_id_v();
        const int lane = tid & 63, wave = wv, gw = vcu * 8 + wave;
        LAS float* scr = (LAS float*)(lds + wave * 16640);
        constexpr int I_GU = 16 * 88, I_D = 44 * 16, I_QKV = 16 * 48, I_O = 16 * 16;
        constexpr int NITEMS = 4 * I_GU + 4 * I_D + I_QKV + 2 * I_O;
        for (int r2 = 0; r2 < NREP(9); ++r2)
        for (int it = gw; it < NITEMS; it += NGW) {
            int q = it;
            if (q < 4 * I_GU) { const int f = q / I_GU; transpose_item(((f & 1) ? ka->in[9] : ka->in[7]) + (size_t)(f >> 1) * DM * NGU, DM, NGU, (bf16*)(P_WS + WS_WGU + f * WGU_SZ), true, scr, q % I_GU, lane); continue; } q -= 4 * I_GU;
            if (q < 4 * I_D) { const int f = q / I_D; transpose_item(((f & 1) ? ka->in[10] : ka->in[8]) + (size_t)(f >> 1) * DFF * DM, DFF, DM, (bf16*)(P_WS + WS_WD + f * WD_SZ), false, scr, q % I_D, lane); continue; } q -= 4 * I_D;
            if (q < I_QKV) { transpose_item(ka->in[11], DM, 3072, P_WQKV, false, scr, q, lane); continue; } q -= I_QKV;
            if (q < I_O) { transpose_item(ka->in[12], DM, DM, P_WO, false, scr, q, lane); continue; } q -= I_O;
            transpose_item(ka->in[20], DM, DM, P_WF, false, scr, q, lane);
        }
        const int gt = vcu * 512 + tid, NGT = G * 512;
        for (int r2 = 0; r2 < NREP(10); ++r2)
        for (int i = gt; i < 2048 * 256; i += NGT) { const int k = i >> 8, j0 = (i & 255) * 8; const bool isS = j0 >= 1024; const int jj = j0 & 1023;
            float v[8];
#pragma unroll
            for (int e = 0; e < 8; ++e) { const int idx = (k * (jj + e)) & 2047; float sn, cs; sincospif((float)idx * (1.0f / 1024.0f), &sn, &cs); v[e] = (isS ? -sn : cs) * 0.02209708691f; }
            u32x4 w; w.x = pk2(v[0], v[1]); w.y = pk2(v[2], v[3]); w.z = pk2(v[4], v[5]); w.w = pk2(v[6], v[7]);
            *(u32x4*)(P_DFTS + (size_t)k * 2048 + j0) = w; }
        for (int i = gt; i < 512 * 32; i += NGT) { const int f = i >> 5, c0 = (i & 31) * 8; const bool isS = f >= 256; const int ff = f & 255;
            float v[8];
#pragma unroll
            for (int e = 0; e < 8; ++e) { const int idx = (ff * (c0 + e)) & 255; float sn, cs; sincospif((float)idx * (1.0f / 128.0f), &sn, &cs); v[e] = (isS ? sn : cs) * 0.0625f; }
            u32x4 w; w.x = pk2(v[0], v[1]); w.y = pk2(v[2], v[3]); w.z = pk2(v[4], v[5]); w.w = pk2(v[6], v[7]);
            *(u32x4*)(P_DFTC + (size_t)f * 256 + c0) = w; }
        if (bid == 0 && wave == 0) {
            float p1 = wave_sum(ka->in[15][lane] * ka->in[16][lane]), p2 = wave_sum(ka->in[17][lane] * ka->in[18][lane]);
            float mq = fabsf(ka->in[13][lane]), mk = fabsf(ka->in[14][lane]);
#pragma unroll
            for (int o = 1; o < 64; o <<= 1) { mq = fmaxf(mq, __shfl_xor(mq, o)); mk = fmaxf(mk, __shfl_xor(mk, o)); }
            if (lane == 0) { P_SCAL[0] = expf(p1) - expf(p2) + 0.2f; P_SCAL[1] = 8.0f * mq * mk * 1.44269504089f; }
        }
    }
    SEAM();

    for (int fi = 0; fi < 4; ++fi) {
#define FI() int fi_ = fi; asm volatile("" : "+s"(fi_)); const int layer = fi_ >> 1, which = fi_ & 1; const bool with_ctx = (fi_ == 0); (void)layer; (void)which; (void)with_ctx
        if (RUN()) for (int rep = 0; rep < NREP(1); ++rep) { KArgs ka = KA(); FI();
            norm_phase((fi_ == 0) ? ka->in[0] : (const float*)P_OUT, ka->in[2], nullptr, ka->in[4] + (size_t)(layer * 3 + which * 2) * DM, P_ADA + (size_t)layer * 17 * NMOD, which * 6, P_HB, with_ctx, vcu, NGW, wv); }
        SEAM();
        if (RUN()) for (int rep = 0; rep < NREP(2); ++rep) {
            if (rep) XBAR();
            KArgs ka = KA(); FI();
            pg8::Gemm g{P_HB, (const bf16*)(P_WS + WS_WGU + fi_ * WGU_SZ), DM, DM, DM, 0u, 0u};
            pg8::Order S; S.init(with_ctx ? 144 : 128, 22, 1, with_ctx ? 0 : 1, 0, G, bid);
            pg8::EpiSwiglu E{P_BIG};
            pg8::gemm_phase<pg8::EpiSwiglu, pg8::Order>(lds, g, S, E, wv);
        }
        SEAM();
        if (RUN()) { KArgs ka = KA(); FI();
            pg8::Gemm g{P_BIG, (const bf16*)(P_WS + WS_WD + fi_ * WD_SZ), DFF, DFF, DFF, 0u, 0u};
            pg8::Order S; S.init(128, 4, 1, 1, 0, G, bid); if (with_ctx) S.ctxsplit = 128;
            pg8::EpiGateRes E{fi_ == 0 ? 1 : 0, layer, which * 6 + 2, 0.5f};
            pg8::gemm_phase<pg8::EpiGateRes, pg8::Order>(lds, g, S, E, wv);
        }
#ifdef TPROBE
        SEAM();
#else
        if (fi < 3) SEAM();
#endif
        if ((fi & 1) == 0) {
            if (RUN()) for (int rep = 0; rep < NREP(7); ++rep) { KArgs ka = KA(); FI();
                if (layer == 0) norm_phase(P_OUT, P_Y1, P_Y1B, ka->in[4] + (size_t)(layer * 3 + 1) * DM, P_ADA + (size_t)layer * 17 * NMOD, 3, P_HB, true, vcu, NGW, wv);
                else norm_fourier_phase(P_OUT, ka->in[4] + (size_t)(layer * 3 + 1) * DM, P_ADA + (size_t)layer * 17 * NMOD, P_HB, (float*)(P_WS + WS_H1024), vcu, NGW, wv); }
            SEAM();
            if (fi == 0) {
                if (RUN()) for (int rep = 0; rep < NREP(5); ++rep) {
                    if (rep) XBAR();
                    { KArgs ka = KA();
                        pg8::Gemm g{P_HB, P_WQKV, DM, DM, DM, 0, 0}; pg8::Order S; S.init(128, 4, 1, 1, 0, G, bid); pg8::EpiQKV E{1};
                        pg8::gemm_phase<pg8::EpiQKV, pg8::Order>(lds, g, S, E, wv); }
                    { KArgs ka = KA();
                        const bf16* WK = P_WQKV + (size_t)1024 * DM; const bf16* WV = P_WQKV + (size_t)2048 * DM;
                        pg8::Gemm g{P_HB, WK, DM, DM, DM, (long long)((const char*)WV - (const char*)P_HB), (long long)((const char*)P_HB - (const char*)WK)};
                        pg8::Order S; S.init(144, 4, 2, 0, 0, G, bid); S.swapg = 1; pg8::EpiQKV E{2};
                        pg8::gemm_phase<pg8::EpiQKV, pg8::Order>(lds, g, S, E, wv); }
                }
                SEAM();
                if (RUN()) for (int rep = 0; rep < NREP(3); ++rep) { KArgs ka = KA();
                    attn_phase(lds, P_BIG, P_BIG + QK_STRIDE, P_BIG + 2 * QK_STRIDE, P_HB, 0.8f, G, bid, wv); }
                SEAM();
            } else {
                if (RUN()) for (int rep = 0; rep < NREP(4); ++rep) {
                    if (rep) XBAR();
                    KArgs ka = KA();
                    pg8::Gemm g{P_DFTC, P_HB, 256, 256, DM, 0u, 512u};
                    pg8::Order S; S.init(1, 128, 4, 0, 1, G, bid); S.chan = 1;
                    pg8::EpiChan E{P_BIG};
                    pg8::gemm_phase<pg8::EpiChan, pg8::Order>(lds, g, S, E, wv);
                    {   KArgs ka = KA();
                        const int tid = wv * 64 + lane_id_v();
                        for (int i8 = vcu * 512 + tid; i8 < NB * 1024 * 8; i8 += G * 512) { const int i = i8 >> 3, part = i8 & 7, b = i >> 10, chn = i & 1023, gq = chn >> 8, m = chn & 255;
                            const f32x4* hp = (const f32x4*)((const float*)(P_WS + WS_H1024) + (size_t)b * DM + gq * 256) + 8 * part; const u32x2* cp = (const u32x2*)(P_DFTC + (size_t)m * 256) + 8 * part;
                            f32x4 hv[8]; u32x2 cw[8];
#pragma unroll
                            for (int c4 = 0; c4 < 8; ++c4) { hv[c4] = hp[c4]; cw[c4] = cp[c4]; }
                            float sum = 0.f;
#pragma unroll
                            for (int c4 = 0; c4 < 8; ++c4) sum += hv[c4].x * bf_lo(cw[c4].x) + hv[c4].y * bf_hi(cw[c4].x) + hv[c4].z * bf_lo(cw[c4].y) + hv[c4].w * bf_hi(cw[c4].y);
                            sum += shx<1>(sum); sum += shx<2>(sum); sum += shx<4>(sum);
                            if (part == 0) ((float*)(P_WS + WS_T))[i] = sum * 0.02209708691f; }
                    }
                }
                SEAM();
                if (RUN()) for (int rep = 0; rep < NREP(4); ++rep) {
                    if (rep) XBAR();
                    KArgs ka = KA();
                    pg8::Gemm g{P_DFTS, P_BIG, 2048, 2048, 2048, 0u, 0u};
                    pg8::Order S; S.init(8, 64, 1, 0, 0, G, bid);
                    pg8::EpiSeq E{P_HB + (size_t)CTX * DM, (const float*)(P_WS + WS_T)};
                    pg8::gemm_phase<pg8::EpiSeq, pg8::Order>(lds, g, S, E, wv);
                }
                SEAM();
            }
            if (RUN()) { KArgs ka = KA(); FI();
                pg8::Gemm g{P_HB, layer == 0 ? P_WO : P_WF, DM, DM, DM, 0u, 0u};
                pg8::Order S; S.init(128, 4, 1, 1, 0, G, bid);
                pg8::EpiGateRes E{0, layer, 5, 1.0f};
                pg8::gemm_phase<pg8::EpiGateRes, pg8::Order>(lds, g, S, E, wv);
            }
            SEAM();
        }
    }
#ifdef TPROBE
    XBAR();
    if (bid == 0 && wv == 0 && lane_id_v() == 0) { KArgs ka = KA(); const float us = (float)(tp2 - tp1) * 0.01f; P_OUT[0] += us * (1.0f / TPSCALE); }
#endif
#undef RUN
#undef SEAM
}

extern "C" void kernel_launch(void* const* d_in, const int* in_sizes, int n_in, void* d_out, int out_size, void* d_ws, size_t ws_size, hipStream_t stream) {
    static int grid = 0;
    if (grid == 0) {
        if (n_in != 21 || ws_size < WS_END) { fprintf(stderr, "kernel_launch: unexpected n_in %d / ws %zu\n", n_in, ws_size); grid = -1; return; }
        int dev = 0, cus = 0, per_cu = 0;
        hipGetDevice(&dev); hipDeviceGetAttribute(&cus, hipDeviceAttributeMultiprocessorCount, dev);
        if (hipFuncSetAttribute((const void*)fwd_kernel, hipFuncAttributeMaxDynamicSharedMemorySize, LDS_BYTES) != hipSuccess) { fprintf(stderr, "kernel_launch: hipFuncSetAttribute failed\n"); grid = -1; return; }
        if (hipOccupancyMaxActiveBlocksPerMultiprocessor(&per_cu, (const void*)fwd_kernel, 512, LDS_BYTES) != hipSuccess || per_cu < 1) { fprintf(stderr, "kernel_launch: occupancy query gave %d\n", per_cu); per_cu = 1; }
        (void)hipGetLastError();
        grid = cus * per_cu;
    }
    if (grid < 0) return;
    if (hipMemsetAsync(d_ws, 0, 16384, stream) != hipSuccess) { fprintf(stderr, "kernel_launch: hipMemsetAsync failed\n"); return; }
    Args a{};
    for (int i = 0; i < 21; ++i) a.in[i] = (const float*)d_in[i];
    a.out = (float*)d_out; a.ws = (unsigned char*)d_ws; a.ph_lo = 0; a.ph_hi = 1000;
    void* kargs[] = {&a};
    hipError_t e = hipLaunchCooperativeKernel((const void*)fwd_kernel, dim3(grid), dim3(512), kargs, LDS_BYTES, stream);
    if (e != hipSuccess) fprintf(stderr, "cooperative launch failed: %s (grid %d)\n", hipGetErrorString(e), grid);
}
```
